# Optimizing an MI355X kernel written in HIP

```python
import jax
import jax.numpy as jnp
from jax import lax
import numpy as np

D_MODEL = 1024
BATCH = 4
SEQ = 8192
DEPTH = 4

HEAD_DIM = 64
N_HEADS = D_MODEL // HEAD_DIM
MIX_WIDTH = N_HEADS * HEAD_DIM
N_MIXERS = 3
Q_BLOCK = 128
ROPE_THETA = 10000.0
EPS = 1e-6
NEG_INF = -1e30
BIG = 1e30
SCALE = HEAD_DIM ** -0.5

NSA_KV_HEADS = 4
NSA_CMP_LEN = 32
NSA_CMP_STRIDE = 16
NSA_SLC_LEN = 64
NSA_TOPK = 16
NSA_WINDOW = 512
NSA_Q_BLOCK = 64
A_IN = MIX_WIDTH + 6 * NSA_KV_HEADS * HEAD_DIM + 3 * N_HEADS + MIX_WIDTH

SWA_KV_HEADS = 2
SWA_WINDOW = 128
B_IN = MIX_WIDTH + 2 * SWA_KV_HEADS * HEAD_DIM + MIX_WIDTH

C_IN = 3 * MIX_WIDTH + N_HEADS + MIX_WIDTH

kernel_name = 'hybrid_nsa_swasink_fox_trunk'


def layer_counts():
    return tuple(len(range(m, DEPTH, N_MIXERS)) for m in range(N_MIXERS))


def rms_norm(x, gain):
    xf = x.astype(jnp.float32)
    y = xf * lax.rsqrt(jnp.mean(xf * xf, axis=-1, keepdims=True) + EPS)
    return (y * gain.astype(jnp.float32)).astype(x.dtype)


def rope(x, positions):
    half = HEAD_DIM // 2
    inv_freq = ROPE_THETA ** (-jnp.arange(half, dtype=jnp.float32) * 2.0 / HEAD_DIM)
    ang = positions.astype(jnp.float32)[:, :, None, None] * inv_freq
    cos, sin = jnp.cos(ang), jnp.sin(ang)
    xf = x.astype(jnp.float32)
    x1, x2 = xf[..., :half], xf[..., half:]
    return jnp.concatenate([x1 * cos - x2 * sin, x2 * cos + x1 * sin], axis=-1).astype(x.dtype)


def split_heads(t, n):
    b, s, _ = t.shape
    return t.reshape(b, s, n, HEAD_DIM)


def q_groups(q, g):
    b, s, h, d = q.shape
    return q.reshape(b, s, g, h // g, d).transpose(0, 2, 3, 1, 4)


def kv_groups(k):
    return k.transpose(0, 2, 1, 3)


def merge_blocks(o):
    n, b, g, r, qb, d = o.shape
    return o.transpose(1, 0, 4, 2, 3, 5).reshape(b, n * qb, g * r * d)


def masked_softmax(s, mask):
    p = jax.nn.softmax(jnp.where(mask, s, NEG_INF), axis=-1)
    return jnp.where(mask, p, 0.0)


def sink_softmax(s, mask, sink):
    s = jnp.where(mask, s, NEG_INF)
    m = jnp.maximum(jnp.max(s, axis=-1, keepdims=True), sink)
    e = jnp.exp(s - m)
    return e / (jnp.sum(e, axis=-1, keepdims=True) + jnp.exp(sink - m))


def window_attend(qb, k_pad, v_pad, q0, t, window, sink=None):
    span = qb.shape[3] + window
    kb = lax.dynamic_slice_in_dim(k_pad, q0, span, axis=2)
    vb = lax.dynamic_slice_in_dim(v_pad, q0, span, axis=2)
    s_pos = q0 - window + jnp.arange(span)
    diff = t[:, None] - s_pos[None, :]
    mask = (diff >= 0) & (diff < window) & (s_pos[None, :] >= 0)
    s = jnp.einsum('bgrqd,bgkd->bgrqk', qb, kb).astype(jnp.float32) * SCALE
    p = masked_softmax(s, mask) if sink is None else sink_softmax(s, mask, sink)
    return jnp.einsum('bgrqk,bgkd->bgrqd', p.astype(vb.dtype), vb)


def nsa_mixer(h, positions, w_in, q_gain, k_gain, cmp_pos, cmp_w1, cmp_w2, w_out):
    b, s, _ = h.shape
    g = NSA_KV_HEADS
    kvd = g * HEAD_DIM
    sizes = [MIX_WIDTH] + [kvd] * 6 + [3 * N_HEADS]
    q, kc, vc, ks, vs, kw, vw, gl, z = jnp.split(h @ w_in, np.cumsum(sizes).tolist(), axis=-1)
    q = q_groups(rope(rms_norm(split_heads(q, N_HEADS), q_gain), positions), g)

    n_cmp = (s - NSA_CMP_LEN) // NSA_CMP_STRIDE + 1
    cmp_idx = np.arange(n_cmp)[:, None] * NSA_CMP_STRIDE + np.arange(NSA_CMP_LEN)[None, :]
    kc = kv_groups(rope(split_heads(kc, g), positions))
    vc = kv_groups(split_heads(vc, g))

    def compress(t, pos_emb, w1, w2):
        blocks = t[:, :, cmp_idx] + pos_emb
        flat = blocks.reshape(b, g, n_cmp, NSA_CMP_LEN * HEAD_DIM)
        return jax.nn.gelu(flat @ w1) @ w2

    k_cmp = rms_norm(compress(kc, cmp_pos[0], cmp_w1[0], cmp_w2[0]), k_gain[0])
    v_cmp = compress(vc, cmp_pos[1], cmp_w1[1], cmp_w2[1])
    cmp_end = jnp.asarray(cmp_idx[:, -1])

    n_blk = s // NSA_SLC_LEN
    top_n = min(NSA_TOPK, n_blk)
    slc_start = np.arange(n_blk) * NSA_SLC_LEN
    ov = np.minimum(cmp_idx[:, -1][:, None], slc_start[None, :] + NSA_SLC_LEN - 1) - np.maximum(cmp_idx[:, 0][:, None], slc_start[None, :]) + 1
    overlap = jnp.asarray(np.clip(ov, 0, None) / NSA_CMP_LEN, jnp.float32)
    k_slc = kv_groups(rope(rms_norm(split_heads(ks, g), k_gain[1]), positions)).reshape(b, g, n_blk, NSA_SLC_LEN, HEAD_DIM)
    v_slc = kv_groups(split_heads(vs, g)).reshape(b, g, n_blk, NSA_SLC_LEN, HEAD_DIM)
    blk_ids = jnp.arange(n_blk)
    gather = jax.vmap(jax.vmap(lambda blocks, ids: blocks[ids]))

    pad = ((0, 0), (0, 0), (NSA_WINDOW, 0), (0, 0))
    k_win = jnp.pad(kv_groups(rope(rms_norm(split_heads(kw, g), k_gain[2]), positions)), pad)
    v_win = jnp.pad(kv_groups(split_heads(vw, g)), pad)

    def block_fn(i):
        q0 = i * NSA_Q_BLOCK
        t = q0 + jnp.arange(NSA_Q_BLOCK)
        qb = lax.dynamic_slice_in_dim(q, q0, NSA_Q_BLOCK, axis=3)
        sc = jnp.einsum('bgrqd,bgcd->bgrqc', qb, k_cmp).astype(jnp.float32) * SCALE
        pc = masked_softmax(sc, cmp_end[None, :] <= t[:, None])
        o_cmp = jnp.einsum('bgrqc,bgcd->bgrqd', pc.astype(v_cmp.dtype), v_cmp)
        imp = jnp.einsum('bgrqc,cn->bgqn', pc, overlap)
        cur = t // NSA_SLC_LEN
        forced = (blk_ids[None, :] == 0) | (blk_ids[None, :] == cur[:, None]) | (blk_ids[None, :] == cur[:, None] - 1)
        imp = jnp.where(forced, BIG, jnp.where(blk_ids[None, :] > cur[:, None], NEG_INF, imp))
        _, sel = lax.top_k(imp, top_n)
        k_sel = gather(k_slc, sel).reshape(b, g, NSA_Q_BLOCK, top_n * NSA_SLC_LEN, HEAD_DIM)
        v_sel = gather(v_slc, sel).reshape(b, g, NSA_Q_BLOCK, top_n * NSA_SLC_LEN, HEAD_DIM)
        pos_sel = (sel[..., None] * NSA_SLC_LEN + jnp.arange(NSA_SLC_LEN)).reshape(b, g, NSA_Q_BLOCK, top_n * NSA_SLC_LEN)
        ss = jnp.einsum('bgrqd,bgqkd->bgrqk', qb, k_sel).astype(jnp.float32) * SCALE
        ps = masked_softmax(ss, (pos_sel <= t[:, None])[:, :, None])
        o_slc = jnp.einsum('bgrqk,bgqkd->bgrqd', ps.astype(v_sel.dtype), v_sel)
        o_win = window_attend(qb, k_win, v_win, q0, t, NSA_WINDOW)
        return o_cmp, o_slc, o_win

    o_cmp, o_slc, o_win = lax.map(block_fn, jnp.arange(s // NSA_Q_BLOCK))
    gates = jax.nn.sigmoid(gl.astype(jnp.float32)).reshape(b, s, 3, N_HEADS, 1).astype(h.dtype)
    o = (gates[:, :, 0] * merge_blocks(o_cmp).reshape(b, s, N_HEADS, HEAD_DIM)
         + gates[:, :, 1] * merge_blocks(o_slc).reshape(b, s, N_HEADS, HEAD_DIM)
         + gates[:, :, 2] * merge_blocks(o_win).reshape(b, s, N_HEADS, HEAD_DIM))
    return (o.reshape(b, s, MIX_WIDTH) * jax.nn.silu(z)) @ w_out


def swa_sink_mixer(h, positions, w_in, q_gain, k_gain, sinks, w_out):
    b, s, _ = h.shape
    g = SWA_KV_HEADS
    kvd = g * HEAD_DIM
    q, k, v, z = jnp.split(h @ w_in, np.cumsum([MIX_WIDTH, kvd, kvd]).tolist(), axis=-1)
    q = q_groups(rope(rms_norm(split_heads(q, N_HEADS), q_gain), positions), g)
    pad = ((0, 0), (0, 0), (SWA_WINDOW, 0), (0, 0))
    k = jnp.pad(kv_groups(rope(rms_norm(split_heads(k, g), k_gain), positions)), pad)
    v = jnp.pad(kv_groups(split_heads(v, g)), pad)
    sink = sinks.astype(jnp.float32).reshape(1, g, N_HEADS // g, 1, 1)

    def block_fn(i):
        q0 = i * Q_BLOCK
        t = q0 + jnp.arange(Q_BLOCK)
        qb = lax.dynamic_slice_in_dim(q, q0, Q_BLOCK, axis=3)
        return window_attend(qb, k, v, q0, t, SWA_WINDOW, sink)

    o = merge_blocks(lax.map(block_fn, jnp.arange(s // Q_BLOCK)))
    return (o * jax.nn.silu(z)) @ w_out


def fox_mixer(h, w_in, forget_bias, q_gain, k_gain, w_out):
    b, s, _ = h.shape
    q, k, v, fl, z = jnp.split(h @ w_in, np.cumsum([MIX_WIDTH] * 3 + [N_HEADS]).tolist(), axis=-1)
    q = q_groups(rms_norm(split_heads(q, N_HEADS), q_gain), N_HEADS)
    k = kv_groups(rms_norm(split_heads(k, N_HEADS), k_gain))
    v = kv_groups(split_heads(v, N_HEADS))
    log_f = jax.nn.log_sigmoid(fl.astype(jnp.float32) + forget_bias.astype(jnp.float32))
    cum = jnp.cumsum(log_f, axis=1).transpose(0, 2, 1)
    s_pos = jnp.arange(s)

    def block_fn(i):
        q0 = i * Q_BLOCK
        t = q0 + jnp.arange(Q_BLOCK)
        qb = lax.dynamic_slice_in_dim(q, q0, Q_BLOCK, axis=3)
        cq = lax.dynamic_slice_in_dim(cum, q0, Q_BLOCK, axis=2)
        decay = cq[:, :, None, :, None] - cum[:, :, None, None, :]
        sc = jnp.einsum('bgrqd,bgkd->bgrqk', qb, k).astype(jnp.float32) * SCALE + decay
        p = masked_softmax(sc, s_pos[None, :] <= t[:, None])
        return jnp.einsum('bgrqk,bgkd->bgrqd', p.astype(v.dtype), v)

    o = merge_blocks(lax.map(block_fn, jnp.arange(s // Q_BLOCK)))
    return (o * jax.nn.silu(z)) @ w_out


def setup_inputs(seed: int = 0) -> dict:
    key = jax.random.key(seed)
    keys = iter(jax.random.split(key, 32))
    n_a, n_b, n_c = layer_counts()

    def nrm(shape, scale):
        return scale * jax.random.normal(next(keys), shape, jnp.float32)

    def gain(shape):
        return 1.0 + nrm(shape, 0.02)

    cmp_flat = NSA_CMP_LEN * HEAD_DIM
    return {
        'x': nrm((BATCH, SEQ, D_MODEL), 1.0),
        'positions': jnp.broadcast_to(jnp.arange(SEQ, dtype=jnp.int32), (BATCH, SEQ)),
        'norm_gains': gain((DEPTH, D_MODEL)),
        'a_w_in': nrm((n_a, D_MODEL, A_IN), D_MODEL ** -0.5),
        'a_q_gain': gain((n_a, HEAD_DIM)),
        'a_k_gain': gain((n_a, 3, HEAD_DIM)),
        'a_cmp_pos': nrm((n_a, 2, NSA_CMP_LEN, HEAD_DIM), 0.1),
        'a_cmp_w1': nrm((n_a, 2, cmp_flat, HEAD_DIM), cmp_flat ** -0.5),
        'a_cmp_w2': nrm((n_a, 2, HEAD_DIM, HEAD_DIM), HEAD_DIM ** -0.5),
        'a_w_out': nrm((n_a, MIX_WIDTH, D_MODEL), MIX_WIDTH ** -0.5),
        'b_w_in': nrm((n_b, D_MODEL, B_IN), D_MODEL ** -0.5),
        'b_q_gain': gain((n_b, HEAD_DIM)),
        'b_k_gain': gain((n_b, HEAD_DIM)),
        'b_sinks': nrm((n_b, N_HEADS), 0.5),
        'b_w_out': nrm((n_b, MIX_WIDTH, D_MODEL), MIX_WIDTH ** -0.5),
        'c_w_in': nrm((n_c, D_MODEL, C_IN), D_MODEL ** -0.5),
        'c_forget_bias': 4.0 + nrm((n_c, N_HEADS), 0.5),
        'c_q_gain': gain((n_c, HEAD_DIM)),
        'c_k_gain': gain((n_c, HEAD_DIM)),
        'c_w_out': nrm((n_c, MIX_WIDTH, D_MODEL), MIX_WIDTH ** -0.5),
    }


def reference(x, positions, norm_gains, a_w_in, a_q_gain, a_k_gain, a_cmp_pos, a_cmp_w1, a_cmp_w2, a_w_out,
              b_w_in, b_q_gain, b_k_gain, b_sinks, b_w_out,
              c_w_in, c_forget_bias, c_q_gain, c_k_gain, c_w_out):
    for i in range(DEPTH):
        j = i // N_MIXERS
        h = rms_norm(x, norm_gains[i])
        mixer = i % N_MIXERS
        if mixer == 0:
            y = nsa_mixer(h, positions, a_w_in[j], a_q_gain[j], a_k_gain[j], a_cmp_pos[j],
                          a_cmp_w1[j], a_cmp_w2[j], a_w_out[j])
        elif mixer == 1:
            y = swa_sink_mixer(h, positions, b_w_in[j], b_q_gain[j], b_k_gain[j], b_sinks[j], b_w_out[j])
        else:
            y = fox_mixer(h, c_w_in[j], c_forget_bias[j], c_q_gain[j], c_k_gain[j], c_w_out[j])
        x = x + y
    return x
```

```cpp
#include <hip/hip_runtime.h>
#include <hip/hip_cooperative_groups.h>
#include <stdint.h>
#include <cstdio>
namespace cg = cooperative_groups;

#ifndef ONE_LAUNCH
#define ONE_LAUNCH 1
#endif

typedef unsigned short bf16_t;
typedef short bf16x8 __attribute__((ext_vector_type(8)));
typedef float f32x4 __attribute__((ext_vector_type(4)));
typedef unsigned u32x4 __attribute__((ext_vector_type(4)));
typedef unsigned u32x2 __attribute__((ext_vector_type(2)));
#define DEV __device__ __forceinline__

constexpr int NB = 4, S = 8192, NT = NB * S, D = 1024;
constexpr float EPS = 1e-6f;
constexpr float LOG2E = 1.4426950408889634f;
constexpr float QSCALE = 0.125f * LOG2E;
constexpr float NEGB = -1e30f;
constexpr int NPHASE = 16;

constexpr size_t MBy = 1ull << 20;
constexpr size_t OFF_WIN = 0;
constexpr size_t OFF_WOUT = 36 * MBy;
constexpr size_t OFF_W1T = 44 * MBy;
constexpr size_t OFF_BIAS1 = 45 * MBy;
constexpr size_t OFF_BAR = 45 * MBy + 65536;
constexpr size_t OFF_COS = 46 * MBy;
constexpr size_t OFF_SIN = 50 * MBy;
constexpr size_t OFF_RSS = 54 * MBy;
constexpr size_t OFF_XB = 56 * MBy;
constexpr size_t OFF_Q = 120 * MBy;
constexpr size_t OFF_ZS = 184 * MBy;
constexpr size_t OFF_KV = 248 * MBy;
constexpr size_t A_KC = 0, A_VC = 16 * MBy, A_KS = 32 * MBy, A_VST = 48 * MBy, A_KW = 64 * MBy, A_VWT = 80 * MBy, A_GATE = 96 * MBy,
                 A_KCMP = 104 * MBy, A_VCMPT = 105 * MBy;
constexpr size_t B_K = 0, B_VT = 8 * MBy;
constexpr size_t C_K = 0, C_VT = 64 * MBy, C_LF = 128 * MBy, C_CUM = 130 * MBy;

constexpr int LDS_BYTES = 65536 + 1024 + 16;

struct Params {
    const float* x; const int* pos; const float* norm_gains;
    const float* a_w_in; const float* a_q_gain; const float* a_k_gain; const float* a_cmp_pos; const float* a_cmp_w1; const float* a_cmp_w2; const float* a_w_out;
    const float* b_w_in; const float* b_q_gain; const float* b_k_gain; const float* b_sinks; const float* b_w_out;
    const float* c_w_in; const float* c_fbias; const float* c_q_gain; const float* c_k_gain; const float* c_w_out;
    float* out; char* ws;
};

typedef __bf16 bf16x2_t __attribute__((ext_vector_type(2)));
typedef float f32x2_t __attribute__((ext_vector_type(2)));
DEV unsigned pk_bf16(float lo, float hi) { const f32x2_t f = {lo, hi}; const bf16x2_t v = __builtin_convertvector(f, bf16x2_t); return __builtin_bit_cast(unsigned, v); }
DEV float bf_lo(unsigned u) { return __uint_as_float(u << 16); }
DEV float bf_hi(unsigned u) { return __uint_as_float(u & 0xffff0000u); }
DEV float ex2(float x) { return __builtin_amdgcn_exp2f(x); }
DEV int swz(int row, int chunk) { return row * 128 + ((chunk ^ ((row >> 1) & 7)) << 4); }
DEV f32x4 mfma16(bf16x8 a, bf16x8 b, f32x4 c) { return __builtin_amdgcn_mfma_f32_16x16x32_bf16(a, b, c, 0, 0, 0); }
DEV float xsum16_32(float v) {
    const unsigned x = __float_as_uint(v);
    const auto r = __builtin_amdgcn_permlane16_swap(x, x, false, false);
    const float y = __uint_as_float(r[0]) + __uint_as_float(r[1]);
    const unsigned yy = __float_as_uint(y);
    const auto r2 = __builtin_amdgcn_permlane32_swap(yy, yy, false, false);
    return __uint_as_float(r2[0]) + __uint_as_float(r2[1]);
}
DEV float xmax16_32(float v) {
    const unsigned x = __float_as_uint(v);
    const auto r = __builtin_amdgcn_permlane16_swap(x, x, false, false);
    const float y = fmaxf(__uint_as_float(r[0]), __uint_as_float(r[1]));
    const unsigned yy = __float_as_uint(y);
    const auto r2 = __builtin_amdgcn_permlane32_swap(yy, yy, false, false);
    return fmaxf(__uint_as_float(r2[0]), __uint_as_float(r2[1]));
}
DEV float qsum4(float v) {
    v += __builtin_bit_cast(float, __builtin_amdgcn_update_dpp(0, __builtin_bit_cast(int, v), 0xB1, 0xF, 0xF, false));
    v += __builtin_bit_cast(float, __builtin_amdgcn_update_dpp(0, __builtin_bit_cast(int, v), 0x4E, 0xF, 0xF, false));
    return v;
}
DEV bf16x8 as_bf16x8(u32x4 v) { return __builtin_bit_cast(bf16x8, v); }

DEV int otid() { int t = threadIdx.x; asm volatile("" : "+v"(t)); return t; }
#define XB_TMO      128
#define XB_XCNT(j)  (256  + 64 * (j))
#define XB_XSUB(j)  (1280 + 64 * (j))
#define XB_XGEN(j)  (2304 + 64 * (j))
#define XB_TOP      3328
#define XB_TOPGEN   3392
#define XCD_BAR_WORDS 3456
#define XB_SPIN_CAP (1u << 18)
#define LAS __attribute__((address_space(3)))

__device__ __forceinline__ unsigned xb_ld(unsigned* p)              { return __hip_atomic_load(p, __ATOMIC_RELAXED, __HIP_MEMORY_SCOPE_AGENT); }
__device__ __forceinline__ unsigned xb_add(unsigned* p, unsigned v) { return __hip_atomic_fetch_add(p, v, __ATOMIC_RELAXED, __HIP_MEMORY_SCOPE_AGENT); }
__device__ __forceinline__ unsigned xb_xcc_id() { return (unsigned)__builtin_amdgcn_s_getreg((3 << 11) | 20) & 0xFu; }
#define XB_SPIN(cond, bar) do { unsigned _sp = 0; while (cond) { __builtin_amdgcn_s_sleep(1); \
    if ((++_sp & 255u) == 0u) { if (xb_ld(&(bar)[XB_TMO])) break; if (_sp > XB_SPIN_CAP) { atomicAdd(&(bar)[XB_TMO], 1u); break; } } } } while (0)

struct XcdBarrier {
    unsigned* bar; unsigned x;
    volatile LAS unsigned* st;
};

__device__ __forceinline__ XcdBarrier xcd_barrier_post(unsigned* bar, volatile LAS unsigned* st) {
    XcdBarrier b; b.bar = bar; b.x = xb_xcc_id(); b.st = st;
    if (threadIdx.x == 0) (void)xb_add(&bar[XB_XCNT(b.x)], 1u);
    return b;
}
__device__ __forceinline__ void xcd_barrier_complete(unsigned* bar, unsigned x, unsigned& nloc, unsigned& nx) {
    const unsigned G = gridDim.x * gridDim.y * gridDim.z;
    unsigned sum, cnt, mine, sp = 0u;
    for (;;) {
        sum = 0u; cnt = 0u; mine = 0u;
#pragma unroll
        for (unsigned j = 0; j < 16; ++j) { const unsigned c = xb_ld(&bar[XB_XCNT(j)]); sum += c; cnt += (c > 0u) ? 1u : 0u; mine = (j == x) ? c : mine; }
        if (sum == G) break;
        __builtin_amdgcn_s_sleep(1);
        if ((++sp & 255u) == 0u) { if (xb_ld(&bar[XB_TMO])) break; if (sp > XB_SPIN_CAP) { atomicAdd(&bar[XB_TMO], 1u); break; } }
    }
    nloc = mine > 0u ? mine : 1u; nx = cnt > 0u ? cnt : 1u;
}

__device__ __forceinline__ void xcd_barrier(const XcdBarrier& b) {
    asm volatile("s_waitcnt vmcnt(0)" ::: "memory");
    __syncthreads();
    if (threadIdx.x == 0) {
        unsigned* bar = b.bar;
        __builtin_amdgcn_s_waitcnt(0);
        unsigned nloc = b.st[0], nx = b.st[1];
        if (nloc == 0u) { xcd_barrier_complete(bar, b.x, nloc, nx); b.st[0] = nloc; b.st[1] = nx; }
        const unsigned old = xb_add(&bar[XB_XSUB(b.x)], 1u);
        const unsigned gen = old / nloc;
        if (old + 1u == (gen + 1u) * nloc) {
            __builtin_amdgcn_fence(__ATOMIC_RELEASE, "agent");
            asm volatile("s_waitcnt vmcnt(0)" ::: "memory");
            const unsigned og = xb_add(&bar[XB_TOP], 1u);
            const unsigned tg = og / nx;
            if (og + 1u == (tg + 1u) * nx) xb_add(&bar[XB_TOPGEN], 1u);
            else XB_SPIN(xb_ld(&bar[XB_TOPGEN]) == tg, bar);
            __builtin_amdgcn_fence(__ATOMIC_ACQUIRE, "agent");
            xb_add(&bar[XB_XGEN(b.x)], 1u);
            asm volatile("s_waitcnt vmcnt(0)" ::: "memory");
        } else {
            XB_SPIN(xb_ld(&bar[XB_XGEN(b.x)]) == gen, bar);
            __builtin_amdgcn_fence(__ATOMIC_ACQUIRE, "agent");
            asm volatile("s_waitcnt vmcnt(0)" ::: "memory");
        }
    }
    __syncthreads();
}


DEV void gbar(unsigned* ctr, unsigned target) {
    asm volatile("s_waitcnt vmcnt(0) lgkmcnt(0)" ::: "memory");
    __syncthreads();
    if (threadIdx.x == 0) {
        __builtin_amdgcn_fence(__ATOMIC_RELEASE, "agent");
        asm volatile("s_waitcnt vmcnt(0)" ::: "memory");
        __hip_atomic_fetch_add(ctr, 1u, __ATOMIC_RELAXED, __HIP_MEMORY_SCOPE_AGENT);
        while (__hip_atomic_load(ctr, __ATOMIC_RELAXED, __HIP_MEMORY_SCOPE_AGENT) < target) __builtin_amdgcn_s_sleep(4);
        __builtin_amdgcn_fence(__ATOMIC_ACQUIRE, "agent");
        asm volatile("s_waitcnt vmcnt(0)" ::: "memory");
    }
    __syncthreads();
}
DEV void dma_barrier() { asm volatile("s_waitcnt vmcnt(0)" ::: "memory"); __syncthreads(); }
DEV int layer_type(int L) { return L % 3; }
DEV int layer_j(int L) { return L / 3; }
DEV int layer_ntn(int type) { return type == 0 ? 29 : (type == 1 ? 18 : 33); }

DEV int snake_idx(int it, int bid, int G) { return it * G + ((it & 1) ? (G - 1 - bid) : bid); }

DEV void wtile(const float* src, int ld, int k0, int c0, int nvalid, const float* gain, bf16_t* dst, int dst_ld, char* lds) {
    float* tile = (float*)lds;
    const int tid = otid();
    {
        const int k = tid >> 2, cs = (tid & 3) * 16;
        const float gk = gain ? gain[k0 + k] : 1.f;
        const float* sp = src + (size_t)(k0 + k) * ld + c0 + cs;
#pragma unroll
        for (int c4 = 0; c4 < 4; ++c4) {
            f32x4 v = {0.f, 0.f, 0.f, 0.f};
            if (cs + c4 * 4 < nvalid) v = *(const f32x4*)(sp + c4 * 4);
#pragma unroll
            for (int e = 0; e < 4; ++e) tile[k * 65 + cs + c4 * 4 + e] = v[e] * gk;
        }
    }
    __syncthreads();
    {
        const int n = tid >> 2, ks = (tid & 3) * 16;
        unsigned w[8];
#pragma unroll
        for (int i = 0; i < 8; ++i) w[i] = pk_bf16(tile[(ks + 2 * i) * 65 + n], tile[(ks + 2 * i + 1) * 65 + n]);
        bf16_t* dp = dst + (size_t)n * dst_ld + k0 + ks;
        *(u32x4*)dp = (u32x4){w[0], w[1], w[2], w[3]};
        *(u32x4*)(dp + 8) = (u32x4){w[4], w[5], w[6], w[7]};
    }
    __syncthreads();
}

DEV void phase_prologue(const Params& p, char* lds) {
    const int tid = otid(), lane = tid & 63, wave = tid >> 6;
    const int G = gridDim.x, bid = blockIdx.x;
    constexpr int N_INCH = 218, N_CH = 282, N_WT = N_CH * 16, N_W1 = 4 * 32;
    for (int u = bid; u < N_WT + N_W1; u += G) {
        if (u < N_WT) {
            const int ch = u >> 4, kt = u & 15;
            if (ch < N_INCH) {
                int L, nc;
                if (ch < 58) { L = 0; nc = ch; } else if (ch < 94) { L = 1; nc = ch - 58; } else if (ch < 160) { L = 2; nc = ch - 94; } else { L = 3; nc = ch - 160; }
                const int type = layer_type(L), j = layer_j(L);
                const float* src; int ld, c0, nv = 64;
                if (type == 0) { src = p.a_w_in + (size_t)j * 1024 * 3632; ld = 3632;
                    if (nc < 40) c0 = 64 * nc; else if (nc < 56) c0 = 2608 + 64 * (nc - 40); else if (nc == 56) { c0 = 2560; nv = 48; } else { c0 = 0; nv = 0; } }
                else if (type == 1) { src = p.b_w_in; ld = 2304; c0 = 64 * nc; }
                else { src = p.c_w_in; ld = 4112;
                    if (nc < 48) c0 = 64 * nc; else if (nc < 64) c0 = 3088 + 64 * (nc - 48); else if (nc == 64) { c0 = 3072; nv = 16; } else { c0 = 0; nv = 0; } }
                bf16_t* dst = (bf16_t*)(p.ws + OFF_WIN + (size_t)L * 9 * MBy) + (size_t)nc * 64 * 1024;
                wtile(src, ld, kt * 64, c0, nv, p.norm_gains + L * 1024, dst, 1024, lds);
            } else {
                const int oc = ch - N_INCH, L = oc >> 4, nc = oc & 15;
                const int type = layer_type(L), j = layer_j(L);
                const float* src = type == 0 ? p.a_w_out + (size_t)j * 1024 * 1024 : (type == 1 ? p.b_w_out : p.c_w_out);
                bf16_t* dst = (bf16_t*)(p.ws + OFF_WOUT + (size_t)L * 2 * MBy) + (size_t)nc * 64 * 1024;
                wtile(src, 1024, kt * 64, nc * 64, 64, nullptr, dst, 1024, lds);
            }
        } else {
            const int v = u - N_WT, m = v >> 5, kt = v & 31;
            const float* src = p.a_cmp_w1 + (size_t)m * 2048 * 64;
            bf16_t* dst = (bf16_t*)(p.ws + OFF_W1T) + (size_t)m * 64 * 2048;
            wtile(src, 64, kt * 64, 0, 64, nullptr, dst, 2048, lds);
        }
    }
    for (int item = bid * 4 + wave; item < 256; item += G * 4) {
        const int m = item >> 6, n = item & 63;
        const float* w1 = p.a_cmp_w1 + (size_t)m * 2048 * 64 + n;
        const float* pf = p.a_cmp_pos + (size_t)m * 2048;
        float acc = 0.f;
#pragma unroll 8
        for (int i = 0; i < 32; ++i) { const int k = lane + 64 * i; acc += pf[k] * w1[(size_t)k * 64]; }
#pragma unroll
        for (int o = 32; o >= 1; o >>= 1) acc += __shfl_xor(acc, o);
        if (lane == 0) ((float*)(p.ws + OFF_BIAS1))[m * 64 + n] = acc;
    }
    {
        float* ct = (float*)(p.ws + OFF_COS); float* st = (float*)(p.ws + OFF_SIN);
        for (int i = bid * 256 + tid; i < NT * 32; i += G * 256) {
            const int tok = i >> 5, f = i & 31;
            const float inv_freq = (float)exp2(-(double)f * (13.287712379549449 / 32.0));
            const float ang = (float)p.pos[tok] * inv_freq;
            double rev = (double)ang * 0.15915494309189535; rev -= rint(rev);
            ct[i] = __builtin_amdgcn_cosf((float)rev);
            st[i] = __builtin_amdgcn_sinf((float)rev);
        }
    }
    {
        bf16_t* xb = (bf16_t*)(p.ws + OFF_XB); float* rss = (float*)(p.ws + OFF_RSS);
        for (int row = bid * 4 + wave; row < NT; row += G * 4) {
            const float* xr = p.x + (size_t)row * 1024;
            float ss = 0.f;
#pragma unroll
            for (int i = 0; i < 4; ++i) {
                const f32x4 v = *(const f32x4*)(xr + (lane + 64 * i) * 4);
                ss += v[0] * v[0] + v[1] * v[1] + v[2] * v[2] + v[3] * v[3];
                *(u32x2*)(xb + (size_t)row * 1024 + (lane + 64 * i) * 4) = (u32x2){pk_bf16(v[0], v[1]), pk_bf16(v[2], v[3])};
            }
#pragma unroll
            for (int o = 32; o >= 1; o >>= 1) ss += __shfl_xor(ss, o);
            if (lane < 16) rss[(size_t)row * 16 + lane] = lane == 0 ? ss : 0.f;
        }
    }
}

DEV void g_load(const bf16_t* A, const bf16_t* Bt, int m0, int n0, int k0, int tid, u32x4 (&ra)[4], u32x4 (&rb)[4]) {
#pragma unroll
    for (int i = 0; i < 4; ++i) {
        const int ci = tid + 256 * i, row = ci >> 3, cc = ci & 7;
        ra[i] = *(const u32x4*)(A + (size_t)(m0 + row) * 1024 + k0 + cc * 8);
        rb[i] = *(const u32x4*)(Bt + (size_t)(n0 + row) * 1024 + k0 + cc * 8);
    }
}
DEV void g_write(char* buf, int tid, const u32x4 (&ra)[4], const u32x4 (&rb)[4]) {
#pragma unroll
    for (int i = 0; i < 4; ++i) {
        const int ci = tid + 256 * i, row = ci >> 3, cc = ci & 7;
        *(u32x4*)(buf + swz(row, cc)) = ra[i];
        *(u32x4*)(buf + 16384 + swz(row, cc)) = rb[i];
    }
}
DEV void g_issue(const bf16_t* A, const bf16_t* Bt, int m0, int n0, int k0, char* slot, int wave, int lane) {
#pragma unroll
    for (int i = 0; i < 4; ++i) {
        const int pc = wave + 4 * i, row = 8 * pc + (lane >> 3), cc = (lane & 7) ^ ((row >> 1) & 7);
        __builtin_amdgcn_global_load_lds((const unsigned*)(A + (size_t)(m0 + row) * 1024 + k0 + cc * 8), (unsigned*)(slot + pc * 1024), 16, 0, 0);
        __builtin_amdgcn_global_load_lds((const unsigned*)(Bt + (size_t)(n0 + row) * 1024 + k0 + cc * 8), (unsigned*)(slot + 16384 + pc * 1024), 16, 0, 0);
    }
}
DEV void g_compute(const char* buf, f32x4 (&acc)[4][4], int wr, int wc, int l15, int g) {
#pragma unroll
    for (int ks = 0; ks < 2; ++ks) {
        bf16x8 af[4], bfr[4];
#pragma unroll
        for (int mi = 0; mi < 4; ++mi) af[mi] = *(const bf16x8*)(buf + swz(wr * 64 + 16 * mi + l15, 4 * ks + g));
#pragma unroll
        for (int nj = 0; nj < 4; ++nj) bfr[nj] = *(const bf16x8*)(buf + 16384 + swz(wc * 64 + 16 * nj + l15, 4 * ks + g));
        __builtin_amdgcn_s_setprio(3);
#pragma unroll
        for (int mi = 0; mi < 4; ++mi)
#pragma unroll
            for (int nj = 0; nj < 4; ++nj) acc[mi][nj] = mfma16(bfr[nj], af[mi], acc[mi][nj]);
        __builtin_amdgcn_s_setprio(0);
    }
}
DEV void gemm_tile(const bf16_t* A, const bf16_t* Bt, int m0, int n0, char* lds, f32x4 (&acc)[4][4], int par = 0, bool pre_next = false, int nm0 = 0, int nn0 = 0) {
    const int tid = otid(), lane = tid & 63, wave = tid >> 6, wr = wave >> 1, wc = wave & 1, l15 = lane & 15, g = lane >> 4;
#pragma unroll
    for (int mi = 0; mi < 4; ++mi)
#pragma unroll
        for (int nj = 0; nj < 4; ++nj) acc[mi][nj] = (f32x4){0.f, 0.f, 0.f, 0.f};
    if (!par) {
        __syncthreads();
        g_issue(A, Bt, m0, n0, 0, lds, wave, lane);
    }
    for (int kt = 0; kt < 16; ++kt) {
        dma_barrier();
        if (kt + 1 < 16) g_issue(A, Bt, m0, n0, (kt + 1) * 64, lds + ((kt + 1 + par) & 1) * 32768, wave, lane);
        g_compute(lds + ((kt + par) & 1) * 32768, acc, wr, wc, l15, g);
    }
    __syncthreads();
    if (pre_next) g_issue(A, Bt, nm0, nn0, 0, lds + 32768, wave, lane);
}
DEV bool gemm_next(int r, int ntn, int& mt, int& nt) {
    const int G = gridDim.x, bid = blockIdx.x;
    if ((G & 7) == 0) {
        const int x = bid & 7, lb = bid >> 3, nlb = G >> 3;
        const int qi = lb + nlb * r;
        if (qi >= 32 * ntn) return false;
        const int mi = qi & 7, rest = qi >> 3;
        nt = rest % ntn; mt = x * 32 + (rest / ntn) * 8 + mi;
        return true;
    }
    const int t = bid + G * r;
    if (t >= 256 * ntn) return false;
    mt = t / ntn; nt = t - mt * ntn;
    return true;
}

enum { K_SKIP = 0, K_Q, K_KHEAD, K_VHEAD_T, K_VHEAD_N, K_Z, K_GATE, K_FL };

DEV void inproj_epilogue(const Params& p, int L, f32x4 (&acc)[4][4], int m0, int n0, char* lds) {
    const int tid = otid(), lane = tid & 63, wave = tid >> 6, wr = wave >> 1, wc = wave & 1, l15 = lane & 15, g = lane >> 4;
    const int type = layer_type(L), j = layer_j(L);
    const int nc = (n0 >> 6) + wc;
    char* kv = p.ws + OFF_KV;
    int kind = K_SKIP; bool do_norm = false, do_rope = false; const float* gain = nullptr; bf16_t* outp = nullptr; int hg = 0, G_ = 1; float oscale = 1.f;
    if (type == 0) {
        if (nc < 16) { kind = K_Q; do_norm = true; do_rope = true; gain = p.a_q_gain + j * 64; hg = nc; oscale = QSCALE; }
        else if (nc < 40) {
            const int sub = (nc - 16) >> 2; hg = (nc - 16) & 3; G_ = 4;
            if (sub == 0) { kind = K_KHEAD; do_rope = true; outp = (bf16_t*)(kv + A_KC); }
            else if (sub == 1) { kind = K_VHEAD_N; outp = (bf16_t*)(kv + A_VC); }
            else if (sub == 2) { kind = K_KHEAD; do_norm = true; do_rope = true; gain = p.a_k_gain + (j * 3 + 1) * 64; outp = (bf16_t*)(kv + A_KS); }
            else if (sub == 3) { kind = K_VHEAD_T; outp = (bf16_t*)(kv + A_VST); }
            else if (sub == 4) { kind = K_KHEAD; do_norm = true; do_rope = true; gain = p.a_k_gain + (j * 3 + 2) * 64; outp = (bf16_t*)(kv + A_KW); }
            else { kind = K_VHEAD_T; outp = (bf16_t*)(kv + A_VWT); }
        } else if (nc < 56) { kind = K_Z; hg = nc - 40; }
        else if (nc == 56) kind = K_GATE;
    } else if (type == 1) {
        if (nc < 16) { kind = K_Q; do_norm = true; do_rope = true; gain = p.b_q_gain; hg = nc; oscale = QSCALE; }
        else if (nc < 18) { kind = K_KHEAD; do_norm = true; do_rope = true; gain = p.b_k_gain; hg = nc - 16; G_ = 2; outp = (bf16_t*)(kv + B_K); }
        else if (nc < 20) { kind = K_VHEAD_T; hg = nc - 18; G_ = 2; outp = (bf16_t*)(kv + B_VT); }
        else { kind = K_Z; hg = nc - 20; }
    } else {
        if (nc < 16) { kind = K_Q; do_norm = true; gain = p.c_q_gain; hg = nc; oscale = QSCALE; }
        else if (nc < 32) { kind = K_KHEAD; do_norm = true; gain = p.c_k_gain; hg = nc - 16; G_ = 16; outp = (bf16_t*)(kv + C_K); }
        else if (nc < 48) { kind = K_VHEAD_T; hg = nc - 32; G_ = 16; outp = (bf16_t*)(kv + C_VT); }
        else if (nc < 64) { kind = K_Z; hg = nc - 48; }
        else if (nc == 64) kind = K_FL;
    }
    if (kind == K_SKIP) return;
    const float* rss = (const float*)(p.ws + OFF_RSS);
    const float* ct = (const float*)(p.ws + OFF_COS); const float* st = (const float*)(p.ws + OFF_SIN);
    char* stg = lds + wave * 8192;
    const int tok0 = m0 + wr * 64, b0 = tok0 >> 13, s0 = tok0 & (S - 1);
    f32x4 gn[4];
#pragma unroll
    for (int nj = 0; nj < 4; ++nj) gn[nj] = gain ? *(const f32x4*)(gain + 16 * nj + 4 * g) : (f32x4){1.f, 1.f, 1.f, 1.f};
    f32x4 fb = {0.f, 0.f, 0.f, 0.f};
    if (kind == K_FL) fb = *(const f32x4*)(p.c_fbias + 4 * g);
#pragma unroll
    for (int mi = 0; mi < 4; ++mi) {
        const int row = 16 * mi + l15, tok = tok0 + row;
        const int b = tok >> 13, sq = tok & (S - 1);
        const f32x4 pp = *(const f32x4*)(rss + (size_t)tok * 16 + 4 * g);
        const float rstd = rsqrtf(xsum16_32((pp[0] + pp[1]) + (pp[2] + pp[3])) * (1.f / 1024.f) + EPS);
        f32x4 v[4];
#pragma unroll
        for (int nj = 0; nj < 4; ++nj) v[nj] = acc[mi][nj] * rstd;
        if (do_norm) {
            float q2 = 0.f;
#pragma unroll
            for (int nj = 0; nj < 4; ++nj) q2 += v[nj][0] * v[nj][0] + v[nj][1] * v[nj][1] + v[nj][2] * v[nj][2] + v[nj][3] * v[nj][3];
            q2 = xsum16_32(q2);
            const float r = rsqrtf(q2 * (1.f / 64.f) + EPS) * oscale;
#pragma unroll
            for (int nj = 0; nj < 4; ++nj) v[nj] = v[nj] * r * gn[nj];
        }
        if (do_rope) {
#pragma unroll
            for (int nj = 0; nj < 2; ++nj) {
                const f32x4 c = *(const f32x4*)(ct + (size_t)tok * 32 + 16 * nj + 4 * g);
                const f32x4 sn = *(const f32x4*)(st + (size_t)tok * 32 + 16 * nj + 4 * g);
                const f32x4 x1 = v[nj], x2 = v[nj + 2];
                v[nj] = x1 * c - x2 * sn;
                v[nj + 2] = x2 * c + x1 * sn;
            }
        }
        if (kind == K_Z) {
#pragma unroll
            for (int nj = 0; nj < 4; ++nj)
#pragma unroll
                for (int r = 0; r < 4; ++r) v[nj][r] = v[nj][r] / (1.f + __expf(-v[nj][r]));
        }
        if (kind == K_VHEAD_T) {
#pragma unroll
            for (int nj = 0; nj < 4; ++nj)
#pragma unroll
                for (int r = 0; r < 4; ++r) {
                    const int d = 16 * nj + 4 * g + r;
                    *(bf16_t*)(stg + d * 128 + (((row >> 3) ^ (d & 7)) << 4) + (row & 7) * 2) = (bf16_t)(pk_bf16(v[nj][r], 0.f) & 0xffffu);
                }
        } else if (kind == K_GATE) {
            float* o = (float*)(kv + A_GATE) + (size_t)tok * 48 + 4 * g;
#pragma unroll
            for (int nj = 0; nj < 3; ++nj) {
                f32x4 w;
#pragma unroll
                for (int r = 0; r < 4; ++r) w[r] = 1.f / (1.f + __expf(-v[nj][r]));
                *(f32x4*)(o + 16 * nj) = w;
            }
        } else if (kind == K_FL) {
            float* o = (float*)(kv + C_LF);
#pragma unroll
            for (int r = 0; r < 4; ++r) {
                const float xv = v[0][r] + fb[r];
                const float ls = fminf(xv, 0.f) - log1pf(__expf(-fabsf(xv)));
                o[(size_t)(b * 16 + 4 * g + r) * S + sq] = ls;
            }
        } else {
#pragma unroll
            for (int nj = 0; nj < 4; ++nj) {
                const int u = 4 * nj + g;
                *(u32x2*)(stg + row * 128 + (((u >> 1) ^ (row & 7)) << 4) + (u & 1) * 8) = (u32x2){pk_bf16(v[nj][0], v[nj][1]), pk_bf16(v[nj][2], v[nj][3])};
            }
        }
    }
    if (kind == K_GATE || kind == K_FL) return;
    bf16_t* obase; size_t ostride;
    if (kind == K_Q) { obase = (bf16_t*)(p.ws + OFF_Q) + (size_t)tok0 * 1024 + hg * 64; ostride = 1024; }
    else if (kind == K_Z) { obase = (bf16_t*)(p.ws + OFF_ZS) + (size_t)tok0 * 1024 + hg * 64; ostride = 1024; }
    else if (kind == K_VHEAD_T) { obase = outp + ((size_t)(b0 * G_ + hg) * 64) * S + s0; ostride = S; }
    else { obase = outp + ((size_t)(b0 * G_ + hg) * S + s0) * 64; ostride = 64; }
#pragma unroll
    for (int it = 0; it < 8; ++it) {
        const int row = 8 * it + (lane >> 3), cp = lane & 7;
        const u32x4 dv = *(const u32x4*)(stg + row * 128 + (cp << 4));
        *(u32x4*)(obase + (size_t)row * ostride + ((cp ^ (row & 7)) << 3)) = dv;
    }
}

DEV void phase_inproj(const Params& p, int L, char* lds) {
    const int type = layer_type(L);
    const int ntn = layer_ntn(type);
    const bf16_t* A = (const bf16_t*)(p.ws + OFF_XB);
    const bf16_t* Bt = (const bf16_t*)(p.ws + OFF_WIN + (size_t)L * 9 * MBy);
    int mt, nt, par = 0;
    bool have = gemm_next(0, ntn, mt, nt);
    for (int r = 0; have; ++r) {
        int mt2 = 0, nt2 = 0;
        const bool have2 = gemm_next(r + 1, ntn, mt2, nt2);
        f32x4 acc[4][4];
        gemm_tile(A, Bt, mt * 128, nt * 128, lds, acc, par, have2, mt2 * 128, nt2 * 128);
        par = have2 ? 1 : 0;
        inproj_epilogue(p, L, acc, mt * 128, nt * 128, lds);
        mt = mt2; nt = nt2; have = have2;
    }
}

DEV void phase_outproj(const Params& p, int L, char* lds) {
    const int tid = otid(), lane = tid & 63, wave = tid >> 6, wr = wave >> 1, wc = wave & 1, l15 = lane & 15, g = lane >> 4;
    const bf16_t* A = (const bf16_t*)(p.ws + OFF_Q);
    const bf16_t* Bt = (const bf16_t*)(p.ws + OFF_WOUT + (size_t)L * 2 * MBy);
    const float* xin = L == 0 ? p.x : p.out;
    float* xout = p.out;
    bf16_t* xb = (bf16_t*)(p.ws + OFF_XB);
    float* rssn = (float*)(p.ws + OFF_RSS);
    char* stg = lds + wave * 16384;
    for (int r = 0;; ++r) {
        int mt, nt;
        if (!gemm_next(r, 8, mt, nt)) break;
        const int m0 = mt * 128, n0 = nt * 128;
        f32x4 acc[4][4];
        gemm_tile(A, Bt, m0, n0, lds, acc);
#pragma unroll
        for (int mi = 0; mi < 4; ++mi)
#pragma unroll
            for (int nj = 0; nj < 4; ++nj) {
                const int row = 16 * mi + l15, c = 4 * nj + g;
                *(f32x4*)(stg + row * 256 + ((c ^ (row & 15)) << 4)) = acc[mi][nj];
            }
        const size_t gbase = (size_t)(m0 + wr * 64) * 1024 + n0 + wc * 64;
#pragma unroll
        for (int it = 0; it < 16; ++it) {
            const int row = 4 * it + g, c = l15 ^ (row & 15);
            const f32x4 av = *(const f32x4*)(stg + row * 256 + (l15 << 4));
            const size_t off = gbase + (size_t)row * 1024 + 4 * c;
            const f32x4 xn = *(const f32x4*)(xin + off) + av;
            *(f32x4*)(xout + off) = xn;
            if (L < 3) *(u32x2*)(xb + off) = (u32x2){pk_bf16(xn[0], xn[1]), pk_bf16(xn[2], xn[3])};
            float ss = xn[0] * xn[0] + xn[1] * xn[1] + xn[2] * xn[2] + xn[3] * xn[3];
            ss += __builtin_bit_cast(float, __builtin_amdgcn_update_dpp(0, __builtin_bit_cast(int, ss), 0x128, 0xF, 0xF, false));
            ss += __builtin_bit_cast(float, __builtin_amdgcn_update_dpp(0, __builtin_bit_cast(int, ss), 0x124, 0xF, 0xF, false));
            ss += __builtin_bit_cast(float, __builtin_amdgcn_update_dpp(0, __builtin_bit_cast(int, ss), 0x122, 0xF, 0xF, false));
            ss += __builtin_bit_cast(float, __builtin_amdgcn_update_dpp(0, __builtin_bit_cast(int, ss), 0x121, 0xF, 0xF, false));
            if (l15 == 0 && L < 3) rssn[(size_t)(m0 + wr * 64 + row) * 16 + 2 * nt + wc] = ss;
        }
    }
}

DEV int swzK(int row, int chunk) { return row * 128 + ((chunk ^ (((row >> 1) & 1) | (((row >> 3) & 3) << 1))) << 4); }
DEV int koff(int nf, int g) { return 32 * (nf >> 1) + 8 * g + 4 * (nf & 1); }
template <bool HASV>
DEV void kv_issue(const bf16_t* kp, size_t krow, const bf16_t* vp, size_t vrow, char* kb, char* vb, int wave, int lane) {
#pragma unroll
    for (int i = 0; i < 2; ++i) {
        const int pc = wave + 4 * i, row = 8 * pc + (lane >> 3), cp = lane & 7;
        const int ck = cp ^ (((row >> 1) & 1) | (((row >> 3) & 3) << 1));
        __builtin_amdgcn_global_load_lds((const unsigned*)(kp + (size_t)row * krow + ck * 8), (unsigned*)(kb + pc * 1024), 16, 0, 0);
        if (HASV) {
            const int cv = cp ^ ((row >> 1) & 7);
            __builtin_amdgcn_global_load_lds((const unsigned*)(vp + (size_t)row * vrow + cv * 8), (unsigned*)(vb + pc * 1024), 16, 0, 0);
        }
    }
}
template <bool HASV, bool HASC, bool REV, class F>
DEV void kv_loop(char* lds, const bf16_t* kbase, size_t ktile, size_t krow, const bf16_t* vbase, size_t vtile, size_t vrow, const float* cbase, int kt_lo, int kt_hi, F&& body) {
    const int tid = otid(), wave = tid >> 6, lane = tid & 63;
    const int n = kt_hi - kt_lo + 1;
    f32x4 rc = {0.f, 0.f, 0.f, 0.f};
    char* c0 = lds + 65536 + 512;
#define KTI(i) (REV ? kt_hi - (i) : kt_lo + (i))
    kv_issue<HASV>(kbase + (size_t)KTI(0) * ktile, krow, vbase + (size_t)KTI(0) * vtile, vrow, lds, lds + 8192, wave, lane);
    if (HASC) { if (tid < 16) rc = *(const f32x4*)(cbase + (size_t)KTI(0) * 64 + 4 * tid); }
    for (int i = 0; i < n; ++i) {
        char* cb_ = lds + (i & 1) * 16384; char* nb_ = lds + ((i + 1) & 1) * 16384;
        if (HASC) { if (tid < 16) *(f32x4*)(c0 + (i & 1) * 256 + 16 * tid) = rc; }
        dma_barrier();
        if (i + 1 < n) {
            kv_issue<HASV>(kbase + (size_t)KTI(i + 1) * ktile, krow, vbase + (size_t)KTI(i + 1) * vtile, vrow, nb_, nb_ + 8192, wave, lane);
            if (HASC) { if (tid < 16) rc = *(const f32x4*)(cbase + (size_t)KTI(i + 1) * 64 + 4 * tid); }
        }
        body(KTI(i), (const char*)cb_, (const char*)(cb_ + 8192), (const char*)(c0 + (i & 1) * 256));
    }
    __syncthreads();
#undef KTI
}
template <class F>
DEV void kv_loop_wide(char* lds, const bf16_t* kbase, size_t ktile, size_t krow, const bf16_t* vbase, size_t vtile, size_t vrow, int kt_lo, int kt_hi, F&& body) {
    const int tid = otid(), wave = tid >> 6, lane = tid & 63;
    const int n = kt_hi - kt_lo + 1, steps = (n + 1) >> 1;
#define KVI2(st, B) { kv_issue<true>(kbase + (size_t)(kt_lo + 2 * (st)) * ktile, krow, vbase + (size_t)(kt_lo + 2 * (st)) * vtile, vrow, (B), (B) + 8192, wave, lane); \
                      if (2 * (st) + 1 < n) kv_issue<true>(kbase + (size_t)(kt_lo + 2 * (st) + 1) * ktile, krow, vbase + (size_t)(kt_lo + 2 * (st) + 1) * vtile, vrow, (B) + 16384, (B) + 16384 + 8192, wave, lane); }
    KVI2(0, lds);
    for (int st = 0; st < steps; ++st) {
        char* cbuf = lds + (st & 1) * 32768; char* nbuf = lds + ((st + 1) & 1) * 32768;
        dma_barrier();
        if (st + 1 < steps) KVI2(st + 1, nbuf);
        body(kt_lo + 2 * st, (const char*)cbuf, (const char*)(cbuf + 8192), (const char*)nullptr);
        if (2 * st + 1 < n) body(kt_lo + 2 * st + 1, (const char*)(cbuf + 16384), (const char*)(cbuf + 16384 + 8192), (const char*)nullptr);
    }
    __syncthreads();
#undef KVI2
}
DEV void qk2(const char* kb, const bf16x8 (&q)[2][2], f32x4 (&s)[2][4], bool a0, bool a1, int l15, int g) {
    __builtin_amdgcn_s_setprio(3);
#pragma unroll
    for (int hf = 0; hf < 2; ++hf) {
        bf16x8 kf[2][2];
#pragma unroll
        for (int i = 0; i < 2; ++i)
#pragma unroll
            for (int ks = 0; ks < 2; ++ks) {
                const int nf = 2 * hf + i;
                kf[i][ks] = *(const bf16x8*)(kb + swzK(32 * (nf >> 1) + 8 * (l15 >> 2) + 4 * (nf & 1) + (l15 & 3), 4 * ks + g));
            }
#pragma unroll
        for (int i = 0; i < 2; ++i) { s[0][2 * hf + i] = (f32x4){0.f, 0.f, 0.f, 0.f}; s[1][2 * hf + i] = (f32x4){0.f, 0.f, 0.f, 0.f}; }
        if (a0) {
#pragma unroll
            for (int i = 0; i < 2; ++i)
#pragma unroll
                for (int ks = 0; ks < 2; ++ks) s[0][2 * hf + i] = mfma16(kf[i][ks], q[0][ks], s[0][2 * hf + i]);
        }
        if (a1) {
#pragma unroll
            for (int i = 0; i < 2; ++i)
#pragma unroll
                for (int ks = 0; ks < 2; ++ks) s[1][2 * hf + i] = mfma16(kf[i][ks], q[1][ks], s[1][2 * hf + i]);
        }
    }
    __builtin_amdgcn_s_setprio(0);
}
DEV void pv2(const char* vb, const f32x4 (&s)[2][4], f32x4 (&o)[2][4], bool a0, bool a1, int l15, int g) {
    __builtin_amdgcn_s_setprio(3);
#pragma unroll
    for (int ks = 0; ks < 2; ++ks) {
        bf16x8 vf[4];
#pragma unroll
        for (int df = 0; df < 4; ++df) vf[df] = *(const bf16x8*)(vb + swz(16 * df + l15, 4 * ks + g));
        if (a0) {
            const bf16x8 pb0 = as_bf16x8((u32x4){pk_bf16(s[0][2 * ks][0], s[0][2 * ks][1]), pk_bf16(s[0][2 * ks][2], s[0][2 * ks][3]),
                                                 pk_bf16(s[0][2 * ks + 1][0], s[0][2 * ks + 1][1]), pk_bf16(s[0][2 * ks + 1][2], s[0][2 * ks + 1][3])});
#pragma unroll
            for (int df = 0; df < 4; ++df) o[0][df] = mfma16(vf[df], pb0, o[0][df]);
        }
        if (a1) {
            const bf16x8 pb1 = as_bf16x8((u32x4){pk_bf16(s[1][2 * ks][0], s[1][2 * ks][1]), pk_bf16(s[1][2 * ks][2], s[1][2 * ks][3]),
                                                 pk_bf16(s[1][2 * ks + 1][0], s[1][2 * ks + 1][1]), pk_bf16(s[1][2 * ks + 1][2], s[1][2 * ks + 1][3])});
#pragma unroll
            for (int df = 0; df < 4; ++df) o[1][df] = mfma16(vf[df], pb1, o[1][df]);
        }
    }
    __builtin_amdgcn_s_setprio(0);
}
typedef float f32x2 __attribute__((ext_vector_type(2)));
DEV f32x2 pk_add(f32x2 a, f32x2 b) { return a + b; }
DEV f32x2 pk_sub(f32x2 a, f32x2 b) { return a - b; }
DEV float lmax16(const f32x4 (&s)[4]) {
    float mx = fmaxf(fmaxf(fmaxf(s[0][0], s[0][1]), fmaxf(s[0][2], s[0][3])), fmaxf(fmaxf(s[1][0], s[1][1]), fmaxf(s[1][2], s[1][3])));
    return fmaxf(mx, fmaxf(fmaxf(fmaxf(s[2][0], s[2][1]), fmaxf(s[2][2], s[2][3])), fmaxf(fmaxf(s[3][0], s[3][1]), fmaxf(s[3][2], s[3][3]))));
}
DEV void sm_rescale(float mxl, float& m, float& l, f32x4 (&o)[4]) {
    const float mx = xmax16_32(mxl), mn = fmaxf(m, mx), alpha = ex2(m - mn);
    l *= alpha; m = mn;
#pragma unroll
    for (int df = 0; df < 4; ++df) o[df] = o[df] * alpha;
}
DEV void sm_exp(f32x4 (&s)[4], float ms, float& l) {
    const f32x2 nm2 = {-ms, -ms};
    f32x2 acc2 = {0.f, 0.f};
#pragma unroll
    for (int nf = 0; nf < 4; ++nf) {
        f32x2 d0 = pk_add((f32x2){s[nf][0], s[nf][1]}, nm2), d1 = pk_add((f32x2){s[nf][2], s[nf][3]}, nm2);
        d0[0] = ex2(d0[0]); d0[1] = ex2(d0[1]); d1[0] = ex2(d1[0]); d1[1] = ex2(d1[1]);
        s[nf] = (f32x4){d0[0], d0[1], d1[0], d1[1]};
        acc2 = pk_add(acc2, pk_add(d0, d1));
    }
    l += acc2[0] + acc2[1];
}
template <bool LANEMASK>
DEV void softmax_step_t(f32x4 (&s)[4], float& m, float& l, f32x4 (&o)[4], bool on) {
    float mxl = lmax16(s);
    if (LANEMASK) mxl = on ? mxl : NEGB;
    if (__ballot(mxl > m + 4.f) != 0ull) sm_rescale(mxl, m, l, o);
    sm_exp(s, LANEMASK ? (on ? m : 1e30f) : m, l);
}
DEV void softmax_step(f32x4 (&s)[4], float& m, float& l, f32x4 (&o)[4]) { softmax_step_t<false>(s, m, l, o, true); }
DEV void softmax_step2(f32x4 (&s)[2][4], float (&m)[2], float (&l)[2], f32x4 (&o)[2][4]) {
    const float mx0 = lmax16(s[0]), mx1 = lmax16(s[1]);
    if (__ballot(mx0 > m[0] + 4.f || mx1 > m[1] + 4.f) != 0ull) { sm_rescale(mx0, m[0], l[0], o[0]); sm_rescale(mx1, m[1], l[1], o[1]); }
    sm_exp(s[0], m[0], l[0]);
    sm_exp(s[1], m[1], l[1]);
}
DEV void load_q(const bf16_t* qp, bf16x8 (&q)[2], int g) {
    q[0] = *(const bf16x8*)(qp + 8 * g);
    q[1] = *(const bf16x8*)(qp + 32 + 8 * g);
}
DEV void store_og(bf16_t* og, const bf16_t* zs, size_t off, const f32x4 (&o)[4]) {
#pragma unroll
    for (int df = 0; df < 4; ++df) {
        const u32x2 z = *(const u32x2*)(zs + off + 16 * df);
        *(u32x2*)(og + off + 16 * df) = (u32x2){pk_bf16(o[df][0] * bf_lo(z[0]), o[df][1] * bf_hi(z[0])), pk_bf16(o[df][2] * bf_lo(z[1]), o[df][3] * bf_hi(z[1]))};
    }
}

DEV bf16x8 pack_p(const f32x4& lo, const f32x4& hi) {
    return as_bf16x8((u32x4){pk_bf16(lo[0], lo[1]), pk_bf16(lo[2], lo[3]), pk_bf16(hi[0], hi[1]), pk_bf16(hi[2], hi[3])});
}
DEV void phase_attn_fox(const Params& p, char* lds) {
    const int tid = otid(), lane = tid & 63, wave = tid >> 6, l15 = lane & 15, g = lane >> 4;
    bf16_t* Q = (bf16_t*)(p.ws + OFF_Q); const bf16_t* ZS = (const bf16_t*)(p.ws + OFF_ZS);
    const bf16_t* K = (const bf16_t*)(p.ws + OFF_KV + C_K); const bf16_t* VT = (const bf16_t*)(p.ws + OFF_KV + C_VT);
    const float* CUM = (const float*)(p.ws + OFF_KV + C_CUM);
    const int G = gridDim.x;
    for (int it = 0;; ++it) {
        int qt, bh;
        if (G == 512) {
            if (it >= 4) break;
            const int x = blockIdx.x & 7, lb = blockIdx.x >> 3, lq = lb & 31;
            bh = x + 8 * (2 * it + (lb >> 5)); qt = (it & 1) ? 31 - lq : lq;
        } else {
            const int idx = snake_idx(it, blockIdx.x, G);
            if (it * G >= 2048) break;
            if (idx >= 2048) continue;
            qt = 31 - (idx >> 6); bh = idx & 63;
        }
        const int b = bh >> 4, h = bh & 15, q0 = qt * 256;
        bf16x8 q[4][2]; float m[4], l[4]; f32x4 o[4][4];
        const int tw = q0 + wave * 64;
#pragma unroll
        for (int mf = 0; mf < 4; ++mf) {
            const int t = tw + mf * 16 + l15;
            load_q(Q + ((size_t)(b * S + t)) * 1024 + h * 64, q[mf], g);
            m[mf] = NEGB; l[mf] = 0.f;
#pragma unroll
            for (int df = 0; df < 4; ++df) o[mf][df] = (f32x4){0.f, 0.f, 0.f, 0.f};
        }
        const float* cl = CUM + (size_t)bh * S;
        kv_loop<true, true, true>(lds, K + (size_t)bh * S * 64, 64 * 64, 64, VT + (size_t)bh * 64 * S, 64, S, cl, 0, 4 * qt + 3,
            [&](int kt, const char* kb, const char* vb, const char* cb) {
                const int key0 = kt * 64;
                if (key0 > tw + 63) return;
                f32x4 ck[4];
#pragma unroll
                for (int nf = 0; nf < 4; ++nf) ck[nf] = *(const f32x4*)(cb + 4 * koff(nf, g));
                bf16x8 pb[4][2];
#pragma unroll
                for (int pr = 0; pr < 2; ++pr) {
                    const int f0 = 2 * pr, f1 = 2 * pr + 1;
                    const bool a0 = key0 <= tw + f0 * 16 + 15, a1 = key0 <= tw + f1 * 16 + 15;
                    if (a1) {
                        f32x4 s[2][4];
                        const bf16x8 (&qq)[2][2] = *(const bf16x8 (*)[2][2])&q[f0];
                        qk2(kb, qq, s, a0, a1, l15, g);
#pragma unroll
                        for (int j = 0; j < 2; ++j) {
                            const int mf = f0 + j;
                            if (j == 0 ? a0 : a1) {
                                const int t = tw + mf * 16 + l15;
#pragma unroll
                                for (int nf = 0; nf < 4; ++nf) s[j][nf] = s[j][nf] - ck[nf];
                                if (key0 + 63 > tw + mf * 16) {
#pragma unroll
                                    for (int nf = 0; nf < 4; ++nf)
#pragma unroll
                                        for (int r = 0; r < 4; ++r) if (key0 + koff(nf, g) + r > t) s[j][nf][r] = NEGB;
                                }
                            }
                        }
                        if (a0) {
                            float (&mm)[2] = *(float (*)[2])&m[f0]; float (&ll)[2] = *(float (*)[2])&l[f0];
                            f32x4 (&oo)[2][4] = *(f32x4 (*)[2][4])&o[f0];
                            softmax_step2(s, mm, ll, oo);
                        } else softmax_step(s[1], m[f1], l[f1], o[f1]);
#pragma unroll
                        for (int ks = 0; ks < 2; ++ks) { pb[f0][ks] = pack_p(s[0][2 * ks], s[0][2 * ks + 1]); pb[f1][ks] = pack_p(s[1][2 * ks], s[1][2 * ks + 1]); }
                    }
                }
                const bool act0 = key0 <= tw + 15, act1 = key0 <= tw + 31, act2 = key0 <= tw + 47;
                __builtin_amdgcn_s_setprio(3);
#pragma unroll
                for (int ks = 0; ks < 2; ++ks) {
                    bf16x8 vf[4];
#pragma unroll
                    for (int df = 0; df < 4; ++df) vf[df] = *(const bf16x8*)(vb + swz(16 * df + l15, 4 * ks + g));
#pragma unroll
                    for (int df = 0; df < 4; ++df) {
                        if (act0) o[0][df] = mfma16(vf[df], pb[0][ks], o[0][df]);
                        if (act1) o[1][df] = mfma16(vf[df], pb[1][ks], o[1][df]);
                        if (act2) o[2][df] = mfma16(vf[df], pb[2][ks], o[2][df]);
                        o[3][df] = mfma16(vf[df], pb[3][ks], o[3][df]);
                    }
                }
                __builtin_amdgcn_s_setprio(0);
            });
#pragma unroll
        for (int mf = 0; mf < 4; ++mf) {
            const int t = tw + mf * 16 + l15;
            const float inv = 1.f / xsum16_32(l[mf]);
#pragma unroll
            for (int df = 0; df < 4; ++df) o[mf][df] = o[mf][df] * inv;
            store_og(Q, ZS, (size_t)(b * S + t) * 1024 + h * 64 + 4 * g, o[mf]);
        }
    }
}

DEV void phase_attn_swa(const Params& p, char* lds) {
    const int tid = otid(), lane = tid & 63, wave = tid >> 6, l15 = lane & 15, g = lane >> 4;
    bf16_t* Q = (bf16_t*)(p.ws + OFF_Q); const bf16_t* ZS = (const bf16_t*)(p.ws + OFF_ZS);
    const bf16_t* K = (const bf16_t*)(p.ws + OFF_KV + B_K); const bf16_t* VT = (const bf16_t*)(p.ws + OFF_KV + B_VT);
    for (int it = 0;; ++it) {
        int idx;
        if (gridDim.x == 512) { if (it >= 8) break; idx = ((blockIdx.x & 7) << 9) + (blockIdx.x >> 3) + 64 * it; }
        else { idx = blockIdx.x + it * gridDim.x; if (idx >= 4096) break; }
        const int b = idx >> 10, gk = (idx >> 9) & 1, tt = idx & 511, t0 = tt * 16;
        bf16x8 q[2][2]; float m[2], l[2]; f32x4 o[2][4]; int tq[2], hd[2];
#pragma unroll
        for (int mf = 0; mf < 2; ++mf) {
            const int rowid = wave * 32 + mf * 16 + l15;
            tq[mf] = t0 + (rowid >> 3); hd[mf] = gk * 8 + (rowid & 7);
            load_q(Q + ((size_t)(b * S + tq[mf])) * 1024 + hd[mf] * 64, q[mf], g);
            m[mf] = p.b_sinks[hd[mf]] * LOG2E; l[mf] = g == 0 ? 1.f : 0.f;
#pragma unroll
            for (int df = 0; df < 4; ++df) o[mf][df] = (f32x4){0.f, 0.f, 0.f, 0.f};
        }
        const int lo = t0 - 127 < 0 ? 0 : t0 - 127;
        const size_t kvh = (size_t)(b * 2 + gk);
        kv_loop<true, false, false>(lds, K + kvh * S * 64, 64 * 64, 64, VT + kvh * 64 * S, 64, S, (const float*)nullptr, lo >> 6, (t0 + 15) >> 6,
            [&](int kt, const char* kb, const char* vb, const char* cb) {
                const int key0 = kt * 64;
                const int tA0 = t0 + wave * 4, tA1 = tA0 + 2;
                const bool a0 = key0 <= tA0 + 1 && key0 + 63 >= tA0 - 127, a1 = key0 <= tA1 + 1 && key0 + 63 >= tA1 - 127;
                if (!a0 && !a1) return;
                f32x4 s[2][4];
                qk2(kb, q, s, a0, a1, l15, g);
#pragma unroll
                for (int mf = 0; mf < 2; ++mf) {
                    if (mf == 0 ? a0 : a1) {
                        const int t = tq[mf];
                        const int tA = mf == 0 ? tA0 : tA1;
                        if (key0 + 63 > tA || key0 <= tA + 1 - 128) {
#pragma unroll
                            for (int nf = 0; nf < 4; ++nf)
#pragma unroll
                                for (int r = 0; r < 4; ++r) {
                                    const int key = key0 + koff(nf, g) + r;
                                    if (key > t || key <= t - 128) s[mf][nf][r] = NEGB;
                                }
                        }
                        softmax_step(s[mf], m[mf], l[mf], o[mf]);
                    } else {
#pragma unroll
                        for (int nf = 0; nf < 4; ++nf) s[mf][nf] = (f32x4){0.f, 0.f, 0.f, 0.f};
                    }
                }
                pv2(vb, s, o, a0, a1, l15, g);
            });
#pragma unroll
        for (int mf = 0; mf < 2; ++mf) {
            const float inv = 1.f / xsum16_32(l[mf]);
#pragma unroll
            for (int df = 0; df < 4; ++df) o[mf][df] = o[mf][df] * inv;
            store_og(Q, ZS, (size_t)(b * S + tq[mf]) * 1024 + hd[mf] * 64 + 4 * g, o[mf]);
        }
    }
}

DEV void phase_attn_nsa(const Params& p, char* lds) {
    const int tid = otid(), lane = tid & 63, wave = tid >> 6, l15 = lane & 15, g = lane >> 4;
    bf16_t* Q = (bf16_t*)(p.ws + OFF_Q); const bf16_t* ZS = (const bf16_t*)(p.ws + OFF_ZS);
    char* kv = p.ws + OFF_KV;
    const bf16_t* KS = (const bf16_t*)(kv + A_KS); const bf16_t* VST = (const bf16_t*)(kv + A_VST);
    const bf16_t* KW = (const bf16_t*)(kv + A_KW); const bf16_t* VWT = (const bf16_t*)(kv + A_VWT);
    const bf16_t* KCMP = (const bf16_t*)(kv + A_KCMP); const bf16_t* VCMPT = (const bf16_t*)(kv + A_VCMPT);
    const float* GATE = (const float*)(kv + A_GATE);
    float* impA = (float*)(lds + 32768); float* impB = (float*)(lds + 49152);
    unsigned char* selb_base = (unsigned char*)(lds + 65536);
    const int G = gridDim.x;
    for (int it = 0;; ++it) {
        int tt, bg;
        if (G == 512) {
            if (it >= 4) break;
            const int x = blockIdx.x & 7, lb = blockIdx.x >> 3;
            bg = x + 8 * (it >> 1); tt = (it & 1) ? 127 - lb : lb;
        } else {
            const int idx = snake_idx(it, blockIdx.x, G);
            if (it * G >= 2048) break;
            if (idx >= 2048) continue;
            tt = 127 - (idx >> 4); bg = idx & 15;
        }
        const int b = bg >> 2, gk = bg & 3, t0 = tt * 64, cur = tt;
        const int hdv = gk * 4 + (l15 & 3);
        const bf16_t* kc = KCMP + (size_t)bg * 512 * 64; const bf16_t* vc = VCMPT + (size_t)bg * 64 * 512;
        bf16x8 q4[4][2]; int tq4[4];
#pragma unroll
        for (int h = 0; h < 2; ++h) {
            const int t0h = t0 + 32 * h, tw = t0h + wave * 8;
            bf16x8 (&q)[2][2] = *(bf16x8 (*)[2][2])&q4[2 * h];
            int (&tq)[2] = *(int (*)[2])&tq4[2 * h];
            int hd[2] = {hdv, hdv};
            unsigned char* selb = selb_base + h * 512;
            float m[2], l[2]; f32x4 o[2][4];
#pragma unroll
            for (int mf = 0; mf < 2; ++mf) {
                tq[mf] = tw + mf * 4 + (l15 >> 2);
                load_q(Q + ((size_t)(b * S + tq[mf])) * 1024 + hd[mf] * 64, q[mf], g);
            }
            const int ct_hi = t0h >> 10;
#pragma unroll
            for (int mf = 0; mf < 2; ++mf) { m[mf] = NEGB; l[mf] = 0.f; }
            kv_loop<false, false, false>(lds, kc, 64 * 64, 64, kc, 0, 0, (const float*)nullptr, 0, ct_hi,
                [&](int kt, const char* kb, const char* vb, const char* cb) {
                    const int c0 = kt * 64;
                    const bool a0 = 16 * c0 + 31 <= tw + 3, a1 = 16 * c0 + 31 <= tw + 7;
                    if (!a1) return;
                    f32x4 s[2][4];
                    qk2(kb, q, s, a0, a1, l15, g);
#pragma unroll
                    for (int mf = 0; mf < 2; ++mf) {
                        if (mf == 0 ? a0 : a1) {
                            const int t = tq[mf];
                            if (16 * (c0 + 63) + 31 > tw + mf * 4) {
#pragma unroll
                                for (int nf = 0; nf < 4; ++nf)
#pragma unroll
                                    for (int r = 0; r < 4; ++r) {
                                        const int c = c0 + koff(nf, g) + r;
                                        if (16 * c + 31 > t) s[mf][nf][r] = NEGB;
                                    }
                            }
                            const float mxl = lmax16(s[mf]);
                            if (__ballot(mxl > m[mf] + 4.f) != 0ull) {
                                const float mx = xmax16_32(mxl), mn = fmaxf(m[mf], mx);
                                l[mf] *= ex2(m[mf] - mn); m[mf] = mn;
                            }
                            sm_exp(s[mf], m[mf], l[mf]);
                        }
                    }
                });
            float invl[2];
#pragma unroll
            for (int mf = 0; mf < 2; ++mf) {
                const float lt = xsum16_32(l[mf]);
                invl[mf] = (m[mf] > -1e29f) ? 1.f / lt : 0.f;
#pragma unroll
                for (int df = 0; df < 4; ++df) o[mf][df] = (f32x4){0.f, 0.f, 0.f, 0.f};
            }
            kv_loop<true, false, false>(lds, kc, 64 * 64, 64, vc, 64, 512, (const float*)nullptr, 0, ct_hi,
                [&](int kt, const char* kb, const char* vb, const char* cb) {
                    const int c0 = kt * 64;
                    const bool a0 = 16 * c0 + 31 <= tw + 3, a1 = 16 * c0 + 31 <= tw + 7;
                    if (!a1) return;
                    f32x4 s[2][4];
                    qk2(kb, q, s, a0, a1, l15, g);
#pragma unroll
                    for (int mf = 0; mf < 2; ++mf) {
                        if (mf == 0 ? a0 : a1) {
                            const int t = tq[mf];
#pragma unroll
                            for (int nf = 0; nf < 4; ++nf) {
                                if (16 * (c0 + 63) + 31 > tw + mf * 4) {
#pragma unroll
                                    for (int r = 0; r < 4; ++r) {
                                        const int c = c0 + koff(nf, g) + r;
                                        if (16 * c + 31 > t) s[mf][nf][r] = NEGB;
                                    }
                                }
                                {
                                    f32x4 d4 = s[mf][nf] - m[mf];
                                    d4[0] = ex2(d4[0]); d4[1] = ex2(d4[1]); d4[2] = ex2(d4[2]); d4[3] = ex2(d4[3]);
                                    s[mf][nf] = d4 * invl[mf];
                                }
                                float av = s[mf][nf][0] + s[mf][nf][1] + s[mf][nf][2] + 0.5f * s[mf][nf][3], bv = 0.5f * s[mf][nf][3];
                                av = qsum4(av); bv = qsum4(bv);
                                if ((l15 & 3) == 0) {
                                    const int tl = wave * 8 + mf * 4 + (l15 >> 2), n = 16 * kt + 8 * (nf >> 1) + 2 * g + (nf & 1);
                                    impA[tl * 128 + n] = av; impB[tl * 128 + n] = bv;
                                }
                            }
                        } else {
#pragma unroll
                            for (int nf = 0; nf < 4; ++nf) s[mf][nf] = (f32x4){0.f, 0.f, 0.f, 0.f};
                        }
                    }
                    pv2(vb, s, o, a0, a1, l15, g);
                });
#pragma unroll
            for (int mf = 0; mf < 2; ++mf) {
                const float gcv = GATE[(size_t)(b * S + tq[mf]) * 48 + hd[mf]];
#pragma unroll
                for (int df = 0; df < 4; ++df) o[mf][df] = o[mf][df] * gcv;
            }
            {
                const int nforced = cur >= 2 ? 3 : cur + 1;
                int niter = cur - 2; if (niter > 16 - nforced) niter = 16 - nforced; if (niter < 0) niter = 0;
#pragma unroll
                for (int r2 = 0; r2 < 2; ++r2) {
                    const int tl = wave * 8 + r2 * 4 + g;
                    unsigned key[8];
                    const f32x4 a0v = *(const f32x4*)(impA + tl * 128 + 8 * l15), a1v = *(const f32x4*)(impA + tl * 128 + 8 * l15 + 4);
#pragma unroll
                    for (int jj = 0; jj < 8; ++jj) {
                        const int n = 8 * l15 + jj;
                        const float av = jj < 4 ? a0v[jj & 3] : a1v[jj & 3];
                        const float bv = n > 0 ? impB[tl * 128 + n - 1] : 0.f;
                        const float val = av + bv;
                        const bool cand = n >= 1 && n <= cur - 2;
                        key[jj] = cand ? ((__float_as_uint(val) & 0xFFFFFF80u) | (unsigned)(127 - n)) : 0u;
                    }
                    unsigned selbits = 0;
                    for (int i2 = 0; i2 < niter; ++i2) {
                        unsigned mx = key[0];
#pragma unroll
                        for (int jj = 1; jj < 8; ++jj) mx = mx > key[jj] ? mx : key[jj];
                        unsigned t2;
                        t2 = (unsigned)__builtin_amdgcn_update_dpp(0, (int)mx, 0x128, 0xF, 0xF, false); mx = mx > t2 ? mx : t2;
                        t2 = (unsigned)__builtin_amdgcn_update_dpp(0, (int)mx, 0x124, 0xF, 0xF, false); mx = mx > t2 ? mx : t2;
                        t2 = (unsigned)__builtin_amdgcn_update_dpp(0, (int)mx, 0x122, 0xF, 0xF, false); mx = mx > t2 ? mx : t2;
                        t2 = (unsigned)__builtin_amdgcn_update_dpp(0, (int)mx, 0x121, 0xF, 0xF, false); mx = mx > t2 ? mx : t2;
#pragma unroll
                        for (int jj = 0; jj < 8; ++jj) if (key[jj] == mx) { selbits |= 1u << jj; key[jj] = 0u; }
                    }
#pragma unroll
                    for (int jj = 0; jj < 8; ++jj) { const int n = 8 * l15 + jj; if (n == 0 || n == cur || n == cur - 1) selbits |= 1u << jj; }
                    selb[tl * 16 + l15] = (unsigned char)selbits;
                }
            }
            __syncthreads();
#pragma unroll
            for (int mf = 0; mf < 2; ++mf) {
                bf16_t* op = Q + (size_t)(b * S + tq[mf]) * 1024 + hd[mf] * 64 + 4 * g;
#pragma unroll
                for (int df = 0; df < 4; ++df) *(u32x2*)(op + 16 * df) = (u32x2){pk_bf16(o[mf][df][0], o[mf][df][1]), pk_bf16(o[mf][df][2], o[mf][df][3])};
            }
        }
        float m4[4], l4[4]; f32x4 o4[4][4];
#pragma unroll
        for (int f = 0; f < 4; ++f) {
            m4[f] = NEGB; l4[f] = 0.f;
#pragma unroll
            for (int df = 0; df < 4; ++df) o4[f][df] = (f32x4){0.f, 0.f, 0.f, 0.f};
        }
        const size_t kvh = (size_t)bg;
        kv_loop_wide(lds, KS + kvh * S * 64, 64 * 64, 64, VST + kvh * 64 * S, 64, S, 0, cur,
            [&](int kt, const char* kb, const char* vb, const char* cb) {
                const int key0 = kt * 64;
                bool bit[4], act[4];
#pragma unroll
                for (int f = 0; f < 4; ++f) {
                    bit[f] = (selb_base[(f >> 1) * 512 + (wave * 8 + (f & 1) * 4 + (l15 >> 2)) * 16 + (kt >> 3)] >> (kt & 7)) & 1;
                    act[f] = __ballot(bit[f]) != 0ull;
                }
                if (!(act[0] || act[1] || act[2] || act[3])) return;
#pragma unroll
                for (int pr = 0; pr < 2; ++pr) {
                    const int f0 = 2 * pr, f1 = 2 * pr + 1;
                    if (act[f0] || act[f1]) {
                        f32x4 s[2][4];
                        const bf16x8 (&qq)[2][2] = *(const bf16x8 (*)[2][2])&q4[f0];
                        qk2(kb, qq, s, act[f0], act[f1], l15, g);
#pragma unroll
                        for (int j = 0; j < 2; ++j) {
                            const int f = f0 + j;
                            if (act[f]) {
                                if (kt < cur) {
                                    softmax_step_t<true>(s[j], m4[f], l4[f], o4[f], bit[f]);
                                } else {
                                    const int t = tq4[f];
#pragma unroll
                                    for (int nf = 0; nf < 4; ++nf)
#pragma unroll
                                        for (int r = 0; r < 4; ++r) {
                                            const int key = key0 + koff(nf, g) + r;
                                            if (!bit[f] || key > t) s[j][nf][r] = NEGB;
                                        }
                                    softmax_step(s[j], m4[f], l4[f], o4[f]);
                                }
                            }
                        }
                        { f32x4 (&oo)[2][4] = *(f32x4 (*)[2][4])&o4[f0]; pv2(vb, s, oo, act[f0], act[f1], l15, g); }
                    }
                }
            });
#pragma unroll
        for (int f = 0; f < 4; ++f) {
            int tqf = tq4[f]; asm volatile("" : "+v"(tqf));
            const float sc = GATE[(size_t)(b * S + tqf) * 48 + 16 + hdv] / xsum16_32(l4[f]);
#pragma unroll
            for (int df = 0; df < 4; ++df) {
                bf16_t* op = Q + (size_t)(b * S + tqf) * 1024 + hdv * 64 + 4 * g + 16 * df;
                const u32x2 pv = *(const u32x2*)op;
                const f32x4 w = (f32x4){bf_lo(pv[0]), bf_hi(pv[0]), bf_lo(pv[1]), bf_hi(pv[1])} + o4[f][df] * sc;
                *(u32x2*)op = (u32x2){pk_bf16(w[0], w[1]), pk_bf16(w[2], w[3])};
                o4[f][df] = (f32x4){0.f, 0.f, 0.f, 0.f};
            }
            m4[f] = NEGB; l4[f] = 0.f;
        }
        {
            const int lo = t0 - 511 < 0 ? 0 : t0 - 511;
            kv_loop_wide(lds, KW + kvh * S * 64, 64 * 64, 64, VWT + kvh * 64 * S, 64, S, lo >> 6, cur,
                [&](int kt, const char* kb, const char* vb, const char* cb) {
                    const int key0 = kt * 64;
                    int tA[4]; bool act[4];
#pragma unroll
                    for (int f = 0; f < 4; ++f) {
                        tA[f] = t0 + 32 * (f >> 1) + wave * 8 + 4 * (f & 1);
                        act[f] = key0 <= tA[f] + 3 && key0 + 63 >= tA[f] - 511;
                    }
                    if (!(act[0] || act[1] || act[2] || act[3])) return;
    #pragma unroll
                    for (int pr = 0; pr < 2; ++pr) {
                        const int f0 = 2 * pr, f1 = 2 * pr + 1;
                        if (act[f0] || act[f1]) {
                            f32x4 s[2][4];
                            const bf16x8 (&qq)[2][2] = *(const bf16x8 (*)[2][2])&q4[f0];
                            qk2(kb, qq, s, act[f0], act[f1], l15, g);
#pragma unroll
                            for (int j = 0; j < 2; ++j) {
                                const int f = f0 + j;
                                if (act[f] && (key0 + 63 > tA[f] || key0 <= tA[f] + 3 - 512)) {
                                    const int t = tq4[f];
#pragma unroll
                                    for (int nf = 0; nf < 4; ++nf)
#pragma unroll
                                        for (int r = 0; r < 4; ++r) {
                                            const int key = key0 + koff(nf, g) + r;
                                            if (key > t || key <= t - 512) s[j][nf][r] = NEGB;
                                        }
                                }
                            }
                            if (act[f0] && act[f1]) {
                                float (&mm)[2] = *(float (*)[2])&m4[f0]; float (&ll)[2] = *(float (*)[2])&l4[f0];
                                f32x4 (&oo)[2][4] = *(f32x4 (*)[2][4])&o4[f0];
                                softmax_step2(s, mm, ll, oo);
                            } else if (act[f0]) softmax_step(s[0], m4[f0], l4[f0], o4[f0]);
                            else softmax_step(s[1], m4[f1], l4[f1], o4[f1]);
                            { f32x4 (&oo)[2][4] = *(f32x4 (*)[2][4])&o4[f0]; pv2(vb, s, oo, act[f0], act[f1], l15, g); }
                        }
                    }
                });
        }
#pragma unroll
        for (int f = 0; f < 4; ++f) {
            int tqf = tq4[f]; asm volatile("" : "+v"(tqf));
            const float sc = GATE[(size_t)(b * S + tqf) * 48 + 32 + hdv] / xsum16_32(l4[f]);
#pragma unroll
            for (int df = 0; df < 4; ++df) {
                const u32x2 pv = *(const u32x2*)(Q + (size_t)(b * S + tqf) * 1024 + hdv * 64 + 4 * g + 16 * df);
                o4[f][df] = (f32x4){bf_lo(pv[0]), bf_hi(pv[0]), bf_lo(pv[1]), bf_hi(pv[1])} + o4[f][df] * sc;
            }
            store_og(Q, ZS, (size_t)(b * S + tqf) * 1024 + hdv * 64 + 4 * g, o4[f]);
        }
    }
}

DEV void phase_cmp(const Params& p, int L, char* lds) {
    const int tid = otid(), lane = tid & 63, wave = tid >> 6, l15 = lane & 15, g = lane >> 4;
    const int j = layer_j(L);
    char* kv = p.ws + OFF_KV;
    for (int item = blockIdx.x; item < 256; item += gridDim.x) {
        const int kvsel = item >> 7, bg = (item >> 3) & 15, ctile = item & 7, mi = j * 2 + kvsel;
        const bf16_t* Asrc = (const bf16_t*)(kv + (kvsel ? A_VC : A_KC)) + ((size_t)bg * S + (size_t)ctile * 64 * 16) * 64;
        const bf16_t* W1t = (const bf16_t*)(p.ws + OFF_W1T) + (size_t)mi * 64 * 2048;
        f32x4 acc[4];
#pragma unroll
        for (int nj = 0; nj < 4; ++nj) acc[nj] = (f32x4){0.f, 0.f, 0.f, 0.f};
        {
            u32x4 ra[2], rw[2];
            auto ld = [&](int kt) {
#pragma unroll
                for (int i = 0; i < 2; ++i) {
                    const int ci = tid + 256 * i, row = ci >> 3, cc = ci & 7;
                    ra[i] = *(const u32x4*)(Asrc + (size_t)row * 1024 + kt * 64 + cc * 8);
                    rw[i] = *(const u32x4*)(W1t + (size_t)row * 2048 + kt * 64 + cc * 8);
                }
            };
            auto wr = [&](char* buf) {
#pragma unroll
                for (int i = 0; i < 2; ++i) {
                    const int ci = tid + 256 * i, row = ci >> 3, cc = ci & 7;
                    *(u32x4*)(buf + swz(row, cc)) = ra[i];
                    *(u32x4*)(buf + 8192 + swz(row, cc)) = rw[i];
                }
            };
            ld(0); wr(lds); __syncthreads();
            for (int kt = 0; kt < 32; ++kt) {
                char* cb = lds + (kt & 1) * 16384; char* nb = lds + ((kt + 1) & 1) * 16384;
                if (kt < 31) ld(kt + 1);
#pragma unroll
                for (int ks = 0; ks < 2; ++ks) {
                    const bf16x8 af = *(const bf16x8*)(cb + swz(16 * wave + l15, 4 * ks + g));
#pragma unroll
                    for (int nj = 0; nj < 4; ++nj) {
                        const bf16x8 wf = *(const bf16x8*)(cb + 8192 + swz(16 * nj + l15, 4 * ks + g));
                        acc[nj] = mfma16(wf, af, acc[nj]);
                    }
                }
                if (kt < 31) wr(nb);
                __syncthreads();
            }
        }
        const float* b1 = (const float*)(p.ws + OFF_BIAS1) + mi * 64;
#pragma unroll
        for (int nj = 0; nj < 4; ++nj) {
            const f32x4 bb = *(const f32x4*)(b1 + 16 * nj + 4 * g);
#pragma unroll
            for (int r = 0; r < 4; ++r) {
                const float x = acc[nj][r] + bb[r];
                const float u = 0.7978845608028654f * (x + 0.044715f * x * x * x);
                const float th = 1.f - 2.f / (1.f + __expf(2.f * u));
                acc[nj][r] = 0.5f * x * (1.f + th);
            }
        }
        const float* w2 = p.a_cmp_w2 + (size_t)mi * 64 * 64;
        f32x4 out[4];
        bf16x8 hb[2];
#pragma unroll
        for (int ks = 0; ks < 2; ++ks)
            hb[ks] = as_bf16x8((u32x4){pk_bf16(acc[2 * ks][0], acc[2 * ks][1]), pk_bf16(acc[2 * ks][2], acc[2 * ks][3]),
                                       pk_bf16(acc[2 * ks + 1][0], acc[2 * ks + 1][1]), pk_bf16(acc[2 * ks + 1][2], acc[2 * ks + 1][3])});
#pragma unroll
        for (int nf = 0; nf < 4; ++nf) {
            out[nf] = (f32x4){0.f, 0.f, 0.f, 0.f};
#pragma unroll
            for (int ks = 0; ks < 2; ++ks) {
                float wv[8];
#pragma unroll
                for (int jj = 0; jj < 8; ++jj) wv[jj] = w2[(size_t)(32 * ks + 16 * (jj >> 2) + 4 * g + (jj & 3)) * 64 + 16 * nf + l15];
                const bf16x8 wf = as_bf16x8((u32x4){pk_bf16(wv[0], wv[1]), pk_bf16(wv[2], wv[3]), pk_bf16(wv[4], wv[5]), pk_bf16(wv[6], wv[7])});
                out[nf] = mfma16(wf, hb[ks], out[nf]);
            }
        }
        const int c = ctile * 64 + 16 * wave + l15;
        if (kvsel == 0) {
            float q2 = 0.f;
#pragma unroll
            for (int nf = 0; nf < 4; ++nf) q2 += out[nf][0] * out[nf][0] + out[nf][1] * out[nf][1] + out[nf][2] * out[nf][2] + out[nf][3] * out[nf][3];
            q2 = xsum16_32(q2);
            const float r = c < 511 ? rsqrtf(q2 * (1.f / 64.f) + EPS) : 0.f;
            const float* gk = p.a_k_gain + (size_t)(j * 3) * 64;
            bf16_t* o = (bf16_t*)(kv + A_KCMP) + ((size_t)bg * 512 + c) * 64 + 4 * g;
#pragma unroll
            for (int nf = 0; nf < 4; ++nf) {
                const f32x4 gg = *(const f32x4*)(gk + 16 * nf + 4 * g);
                f32x4 w = out[nf] * r * gg;
                if (c >= 511) w = (f32x4){0.f, 0.f, 0.f, 0.f};
                *(u32x2*)(o + 16 * nf) = (u32x2){pk_bf16(w[0], w[1]), pk_bf16(w[2], w[3])};
            }
        } else {
            bf16_t* o = (bf16_t*)(kv + A_VCMPT) + ((size_t)bg * 64 + 4 * g) * 512 + c;
#pragma unroll
            for (int nf = 0; nf < 4; ++nf)
#pragma unroll
                for (int r = 0; r < 4; ++r) o[(size_t)(16 * nf + r) * 512] = c < 511 ? (bf16_t)(pk_bf16(out[nf][r], 0.f) & 0xffffu) : (bf16_t)0;
        }
    }
}

DEV void phase_cum(const Params& p, char* lds) {
    const int tid = otid(), lane = tid & 63, wave = tid >> 6;
    float* wtot = (float*)lds;
    const float* LF = (const float*)(p.ws + OFF_KV + C_LF); float* CUM = (float*)(p.ws + OFF_KV + C_CUM);
    for (int bh = blockIdx.x; bh < 64; bh += gridDim.x) {
        const float* src = LF + (size_t)bh * S + tid * 32;
        float v[32];
#pragma unroll
        for (int i = 0; i < 8; ++i) { const f32x4 x = *(const f32x4*)(src + 4 * i); v[4 * i] = x[0]; v[4 * i + 1] = x[1]; v[4 * i + 2] = x[2]; v[4 * i + 3] = x[3]; }
#pragma unroll
        for (int i = 1; i < 32; ++i) v[i] += v[i - 1];
        float inc = v[31];
#pragma unroll
        for (int o = 1; o < 64; o <<= 1) { const float u = __shfl_up(inc, o); if (lane >= o) inc += u; }
        if (lane == 63) wtot[wave] = inc;
        __syncthreads();
        float base = inc - v[31];
        for (int w = 0; w < wave; ++w) base += wtot[w];
        float* dst = CUM + (size_t)bh * S + tid * 32;
#pragma unroll
        for (int i = 0; i < 8; ++i) *(f32x4*)(dst + 4 * i) = (f32x4){(v[4 * i] + base) * LOG2E, (v[4 * i + 1] + base) * LOG2E, (v[4 * i + 2] + base) * LOG2E, (v[4 * i + 3] + base) * LOG2E};
        __syncthreads();
    }
}

#define PHASE(i, call) { if (ph_lo <= (i) && (i) < ph_hi) { call; if (coop && (i) + 1 < ph_hi) { if (coop == 2) grid.sync(); else xcd_barrier(xb); } } }
__global__ void __launch_bounds__(256, 2) hybrid_trunk_kernel(Params p, int ph_lo, int ph_hi, int coop) {
    __shared__ __attribute__((aligned(16))) char lds[LDS_BYTES];
    cg::grid_group grid = cg::this_grid();
    unsigned* bar = (unsigned*)(p.ws + OFF_BAR);
    XcdBarrier xb; xb.bar = bar; xb.x = 0; xb.st = (volatile LAS unsigned*)(lds + 65536 + 1024);
    if (coop) {
        if (threadIdx.x < 2) xb.st[threadIdx.x] = 0u;
        __syncthreads();
        xb = xcd_barrier_post(bar, xb.st);
    }
    PHASE(0, phase_prologue(p, lds))
    PHASE(1, phase_inproj(p, 0, lds))
    PHASE(2, phase_cmp(p, 0, lds))
    PHASE(3, phase_attn_nsa(p, lds))
    PHASE(4, phase_outproj(p, 0, lds))
    PHASE(5, phase_inproj(p, 1, lds))
    PHASE(6, phase_attn_swa(p, lds))
    PHASE(7, phase_outproj(p, 1, lds))
    PHASE(8, phase_inproj(p, 2, lds))
    PHASE(9, phase_cum(p, lds))
    PHASE(10, phase_attn_fox(p, lds))
    PHASE(11, phase_outproj(p, 2, lds))
    PHASE(12, phase_inproj(p, 3, lds))
    PHASE(13, phase_cmp(p, 3, lds))
    PHASE(14, phase_attn_nsa(p, lds))
    PHASE(15, phase_outproj(p, 3, lds))
}

extern "C" void kernel_launch(void* const* d_in, const int* in_sizes, int n_in, void* d_out, int out_size, void* d_ws, size_t ws_size, hipStream_t stream) {
    static int grid_blocks = 0;
    if (!grid_blocks) {
        int dev = 0, cus = 0, per_cu = 0;
        hipGetDevice(&dev);
        hipDeviceGetAttribute(&cus, hipDeviceAttributeMultiprocessorCount, dev);
        hipOccupancyMaxActiveBlocksPerMultiprocessor(&per_cu, hybrid_trunk_kernel, 256, 0);
        if (per_cu > 2) per_cu = 2;
        if (per_cu < 1) per_cu = 1;
        grid_blocks = cus * per_cu;
    }
    Params p{};
    p.x = (const float*)d_in[0]; p.pos = (const int*)d_in[1]; p.norm_gains = (const float*)d_in[2];
    p.a_w_in = (const float*)d_in[3]; p.a_q_gain = (const float*)d_in[4]; p.a_k_gain = (const float*)d_in[5]; p.a_cmp_pos = (const float*)d_in[6];
    p.a_cmp_w1 = (const float*)d_in[7]; p.a_cmp_w2 = (const float*)d_in[8]; p.a_w_out = (const float*)d_in[9];
    p.b_w_in = (const float*)d_in[10]; p.b_q_gain = (const float*)d_in[11]; p.b_k_gain = (const float*)d_in[12]; p.b_sinks = (const float*)d_in[13]; p.b_w_out = (const float*)d_in[14];
    p.c_w_in = (const float*)d_in[15]; p.c_fbias = (const float*)d_in[16]; p.c_q_gain = (const float*)d_in[17]; p.c_k_gain = (const float*)d_in[18]; p.c_w_out = (const float*)d_in[19];
    p.out = (float*)d_out; p.ws = (char*)d_ws;
#if ONE_LAUNCH
    hipMemsetAsync((char*)d_ws + OFF_BAR, 0, XCD_BAR_WORDS * 4, stream);
    int lo = 0, hi = NPHASE, coop = 1;
    void* args[] = {&p, &lo, &hi, &coop};
    hipError_t e = hipLaunchCooperativeKernel((void*)hybrid_trunk_kernel, dim3(grid_blocks), dim3(256), args, 0, stream);
    if (e != hipSuccess) fprintf(stderr, "cooperative launch failed: %s (grid %d)\n", hipGetErrorString(e), grid_blocks);
#else
#ifdef PHASE_LIST
    const int plist[] = PHASE_LIST;
    for (int i = 0; i < (int)(sizeof(plist) / sizeof(int)); ++i) hybrid_trunk_kernel<<<dim3(grid_blocks), dim3(256), 0, stream>>>(p, plist[i], plist[i] + 1, 0);
#else
    for (int ph = 0; ph < NPHASE; ++ph) hybrid_trunk_kernel<<<dim3(grid_blocks), dim3(256), 0, stream>>>(p, ph, ph + 1, 0);
#endif
#endif
}
```

```cpp
#include <hip/hip_runtime.h>
#include <hip/hip_cooperative_groups.h>
#include <stdint.h>
#include <cstdio>
namespace cg = cooperative_groups;

#ifndef ONE_LAUNCH
#define ONE_LAUNCH 1
#endif

typedef unsigned short bf16_t;
typedef short bf16x8 __attribute__((ext_vector_type(8)));
typedef float f32x4 __attribute__((ext_vector_type(4)));
typedef unsigned u32x4 __attribute__((ext_vector_type(4)));
typedef unsigned u32x2 __attribute__((ext_vector_type(2)));
#define DEV __device__ __forceinline__

constexpr int NB = 4, S = 8192, NT = NB * S, D = 1024;
constexpr float EPS = 1e-6f;
constexpr float LOG2E = 1.4426950408889634f;
constexpr float QSCALE = 0.125f * LOG2E;
constexpr float NEGB = -1e30f;
constexpr int NPHASE = 16;

constexpr size_t MBy = 1ull << 20;
constexpr size_t OFF_WIN = 0;
constexpr size_t OFF_WOUT = 36 * MBy;
constexpr size_t OFF_W1T = 44 * MBy;
constexpr size_t OFF_BIAS1 = 45 * MBy;
constexpr size_t OFF_BAR = 45 * MBy + 65536;
constexpr size_t OFF_COS = 46 * MBy;
constexpr size_t OFF_SIN = 50 * MBy;
constexpr size_t OFF_RSS = 54 * MBy;
constexpr size_t OFF_XB = 56 * MBy;
constexpr size_t OFF_Q = 120 * MBy;
constexpr size_t OFF_ZS = 184 * MBy;
constexpr size_t OFF_KV = 248 * MBy;
constexpr size_t A_KC = 0, A_VC = 16 * MBy, A_KS = 32 * MBy, A_VST = 48 * MBy, A_KW = 64 * MBy, A_VWT = 80 * MBy, A_GATE = 96 * MBy,
                 A_KCMP = 104 * MBy, A_VCMPT = 105 * MBy;
constexpr size_t B_K = 0, B_VT = 8 * MBy;
constexpr size_t C_K = 0, C_VT = 64 * MBy, C_LF = 128 * MBy, C_CUM = 130 * MBy;

constexpr int LDS_BYTES = 65536 + 1024 + 16;

struct Params {
    const float* x; const int* pos; const float* norm_gains;
    const float* a_w_in; const float* a_q_gain; const float* a_k_gain; const float* a_cmp_pos; const float* a_cmp_w1; const float* a_cmp_w2; const float* a_w_out;
    const float* b_w_in; const float* b_q_gain; const float* b_k_gain; const float* b_sinks; const float* b_w_out;
    const float* c_w_in; const float* c_fbias; const float* c_q_gain; const float* c_k_gain; const float* c_w_out;
    float* out; char* ws;
};

typedef __bf16 bf16x2_t __attribute__((ext_vector_type(2)));
typedef float f32x2_t __attribute__((ext_vector_type(2)));
DEV unsigned pk_bf16(float lo, float hi) { const f32x2_t f = {lo, hi}; const bf16x2_t v = __builtin_convertvector(f, bf16x2_t); return __builtin_bit_cast(unsigned, v); }
DEV float bf_lo(unsigned u) { return __uint_as_float(u << 16); }
DEV float bf_hi(unsigned u) { return __uint_as_float(u & 0xffff0000u); }
DEV float ex2(float x) { return __builtin_amdgcn_exp2f(x); }
DEV int swz(int row, int chunk) { return row * 128 + ((chunk ^ ((row >> 1) & 7)) << 4); }
DEV f32x4 mfma16(bf16x8 a, bf16x8 b, f32x4 c) { return __builtin_amdgcn_mfma_f32_16x16x32_bf16(a, b, c, 0, 0, 0); }
DEV float xsum16_32(float v) {
    const unsigned x = __float_as_uint(v);
    const auto r = __builtin_amdgcn_permlane16_swap(x, x, false, false);
    const float y = __uint_as_float(r[0]) + __uint_as_float(r[1]);
    const unsigned yy = __float_as_uint(y);
    const auto r2 = __builtin_amdgcn_permlane32_swap(yy, yy, false, false);
    return __uint_as_float(r2[0]) + __uint_as_float(r2[1]);
}
DEV float xmax16_32(float v) {
    const unsigned x = __float_as_uint(v);
    const auto r = __builtin_amdgcn_permlane16_swap(x, x, false, false);
    const float y = fmaxf(__uint_as_float(r[0]), __uint_as_float(r[1]));
    const unsigned yy = __float_as_uint(y);
    const auto r2 = __builtin_amdgcn_permlane32_swap(yy, yy, false, false);
    return fmaxf(__uint_as_float(r2[0]), __uint_as_float(r2[1]));
}
DEV float qsum4(float v) {
    v += __builtin_bit_cast(float, __builtin_amdgcn_update_dpp(0, __builtin_bit_cast(int, v), 0xB1, 0xF, 0xF, false));
    v += __builtin_bit_cast(float, __builtin_amdgcn_update_dpp(0, __builtin_bit_cast(int, v), 0x4E, 0xF, 0xF, false));
    return v;
}
DEV bf16x8 as_bf16x8(u32x4 v) { return __builtin_bit_cast(bf16x8, v); }

DEV int otid() { int t = threadIdx.x; asm volatile("" : "+v"(t)); return t; }
#define XB_TMO      128
#define XB_XCNT(j)  (256  + 64 * (j))
#define XB_XSUB(j)  (1280 + 64 * (j))
#define XB_XGEN(j)  (2304 + 64 * (j))
#define XB_TOP      3328
#define XB_TOPGEN   3392
#define XCD_BAR_WORDS 3456
#define XB_SPIN_CAP (1u << 18)
#define LAS __attribute__((address_space(3)))

__device__ __forceinline__ unsigned xb_ld(unsigned* p)              { return __hip_atomic_load(p, __ATOMIC_RELAXED, __HIP_MEMORY_SCOPE_AGENT); }
__device__ __forceinline__ unsigned xb_add(unsigned* p, unsigned v) { return __hip_atomic_fetch_add(p, v, __ATOMIC_RELAXED, __HIP_MEMORY_SCOPE_AGENT); }
__device__ __forceinline__ unsigned xb_xcc_id() { return (unsigned)__builtin_amdgcn_s_getreg((3 << 11) | 20) & 0xFu; }
#define XB_SPIN(cond, bar) do { unsigned _sp = 0; while (cond) { __builtin_amdgcn_s_sleep(1); \
    if ((++_sp & 255u) == 0u) { if (xb_ld(&(bar)[XB_TMO])) break; if (_sp > XB_SPIN_CAP) { atomicAdd(&(bar)[XB_TMO], 1u); break; } } } } while (0)

struct XcdBarrier {
    unsigned* bar; unsigned x;
    volatile LAS unsigned* st;
};

__device__ __forceinline__ XcdBarrier xcd_barrier_post(unsigned* bar, volatile LAS unsigned* st) {
    XcdBarrier b; b.bar = bar; b.x = xb_xcc_id(); b.st = st;
    if (threadIdx.x == 0) (void)xb_add(&bar[XB_XCNT(b.x)], 1u);
    return b;
}
__device__ __forceinline__ void xcd_barrier_complete(unsigned* bar, unsigned x, unsigned& nloc, unsigned& nx) {
    const unsigned G = gridDim.x * gridDim.y * gridDim.z;
    unsigned sum, cnt, mine, sp = 0u;
    for (;;) {
        sum = 0u; cnt = 0u; mine = 0u;
#pragma unroll
        for (unsigned j = 0; j < 16; ++j) { const unsigned c = xb_ld(&bar[XB_XCNT(j)]); sum += c; cnt += (c > 0u) ? 1u : 0u; mine = (j == x) ? c : mine; }
        if (sum == G) break;
        __builtin_amdgcn_s_sleep(1);
        if ((++sp & 255u) == 0u) { if (xb_ld(&bar[XB_TMO])) break; if (sp > XB_SPIN_CAP) { atomicAdd(&bar[XB_TMO], 1u); break; } }
    }
    nloc = mine > 0u ? mine : 1u; nx = cnt > 0u ? cnt : 1u;
}

__device__ __forceinline__ void xcd_barrier(const XcdBarrier& b) {
    asm volatile("s_waitcnt vmcnt(0)" ::: "memory");
    __syncthreads();
    if (threadIdx.x == 0) {
        unsigned* bar = b.bar;
        __builtin_amdgcn_s_waitcnt(0);
        unsigned nloc = b.st[0], nx = b.st[1];
        if (nloc == 0u) { xcd_barrier_complete(bar, b.x, nloc, nx); b.st[0] = nloc; b.st[1] = nx; }
        const unsigned old = xb_add(&bar[XB_XSUB(b.x)], 1u);
        const unsigned gen = old / nloc;
        if (old + 1u == (gen + 1u) * nloc) {
            __builtin_amdgcn_fence(__ATOMIC_RELEASE, "agent");
            asm volatile("s_waitcnt vmcnt(0)" ::: "memory");
            const unsigned og = xb_add(&bar[XB_TOP], 1u);
            const unsigned tg = og / nx;
            if (og + 1u == (tg + 1u) * nx) xb_add(&bar[XB_TOPGEN], 1u);
            else XB_SPIN(xb_ld(&bar[XB_TOPGEN]) == tg, bar);
            __builtin_amdgcn_fence(__ATOMIC_ACQUIRE, "agent");
            xb_add(&bar[XB_XGEN(b.x)], 1u);
            asm volatile("s_waitcnt vmcnt(0)" ::: "memory");
        } else {
            XB_SPIN(xb_ld(&bar[XB_XGEN(b.x)]) == gen, bar);
            __builtin_amdgcn_fence(__ATOMIC_ACQUIRE, "agent");
            asm volatile("s_waitcnt vmcnt(0)" ::: "memory");
        }
    }
    __syncthreads();
}


DEV void gbar(unsigned* ctr, unsigned target) {
    asm volatile("s_waitcnt vmcnt(0) lgkmcnt(0)" ::: "memory");
    __syncthreads();
    if (threadIdx.x == 0) {
        __builtin_amdgcn_fence(__ATOMIC_RELEASE, "agent");
        asm volatile("s_waitcnt vmcnt(0)" ::: "memory");
        __hip_atomic_fetch_add(ctr, 1u, __ATOMIC_RELAXED, __HIP_MEMORY_SCOPE_AGENT);
        while (__hip_atomic_load(ctr, __ATOMIC_RELAXED, __HIP_MEMORY_SCOPE_AGENT) < target) __builtin_amdgcn_s_sleep(4);
        __builtin_amdgcn_fence(__ATOMIC_ACQUIRE, "agent");
        asm volatile("s_waitcnt vmcnt(0)" ::: "memory");
    }
    __syncthreads();
}
DEV void dma_barrier() { asm volatile("s_waitcnt vmcnt(0)" ::: "memory"); __syncthreads(); }
DEV int layer_type(int L) { return L % 3; }
DEV int layer_j(int L) { return L / 3; }
DEV int layer_ntn(int type) { return type == 0 ? 29 : (type == 1 ? 18 : 33); }

DEV int snake_idx(int it, int bid, int G) { return it * G + ((it & 1) ? (G - 1 - bid) : bid); }

DEV void wtile(const float* src, int ld, int k0, int c0, int nvalid, const float* gain, bf16_t* dst, int dst_ld, char* lds) {
    float* tile = (float*)lds;
    const int tid = otid();
    {
        const int k = tid >> 2, cs = (tid & 3) * 16;
        const float gk = gain ? gain[k0 + k] : 1.f;
        const float* sp = src + (size_t)(k0 + k) * ld + c0 + cs;
#pragma unroll
        for (int c4 = 0; c4 < 4; ++c4) {
            f32x4 v = {0.f, 0.f, 0.f, 0.f};
            if (cs + c4 * 4 < nvalid) v = *(const f32x4*)(sp + c4 * 4);
#pragma unroll
            for (int e = 0; e < 4; ++e) tile[k * 65 + cs + c4 * 4 + e] = v[e] * gk;
        }
    }
    __syncthreads();
    {
        const int n = tid >> 2, ks = (tid & 3) * 16;
        unsigned w[8];
#pragma unroll
        for (int i = 0; i < 8; ++i) w[i] = pk_bf16(tile[(ks + 2 * i) * 65 + n], tile[(ks + 2 * i + 1) * 65 + n]);
        bf16_t* dp = dst + (size_t)n * dst_ld + k0 + ks;
        *(u32x4*)dp = (u32x4){w[0], w[1], w[2], w[3]};
        *(u32x4*)(dp + 8) = (u32x4){w[4], w[5], w[6], w[7]};
    }
    __syncthreads();
}

DEV void phase_prologue(const Params& p, char* lds) {
    const int tid = otid(), lane = tid & 63, wave = tid >> 6;
    const int G = gridDim.x, bid = blockIdx.x;
    constexpr int N_INCH = 218, N_CH = 282, N_WT = N_CH * 16, N_W1 = 4 * 32;
    for (int u = bid; u < N_WT + N_W1; u += G) {
        if (u < N_WT) {
            const int ch = u >> 4, kt = u & 15;
            if (ch < N_INCH) {
                int L, nc;
                if (ch < 58) { L = 0; nc = ch; } else if (ch < 94) { L = 1; nc = ch - 58; } else if (ch < 160) { L = 2; nc = ch - 94; } else { L = 3; nc = ch - 160; }
                const int type = layer_type(L), j = layer_j(L);
                const float* src; int ld, c0, nv = 64;
                if (type == 0) { src = p.a_w_in + (size_t)j * 1024 * 3632; ld = 3632;
                    if (nc < 40) c0 = 64 * nc; else if (nc < 56) c0 = 2608 + 64 * (nc - 40); else if (nc == 56) { c0 = 2560; nv = 48; } else { c0 = 0; nv = 0; } }
                else if (type == 1) { src = p.b_w_in; ld = 2304; c0 = 64 * nc; }
                else { src = p.c_w_in; ld = 4112;
                    if (nc < 48) c0 = 64 * nc; else if (nc < 64) c0 = 3088 + 64 * (nc - 48); else if (nc == 64) { c0 = 3072; nv = 16; } else { c0 = 0; nv = 0; } }
                bf16_t* dst = (bf16_t*)(p.ws + OFF_WIN + (size_t)L * 9 * MBy) + (size_t)nc * 64 * 1024;
                wtile(src, ld, kt * 64, c0, nv, p.norm_gains + L * 1024, dst, 1024, lds);
            } else {
                const int oc = ch - N_INCH, L = oc >> 4, nc = oc & 15;
                const int type = layer_type(L), j = layer_j(L);
                const float* src = type == 0 ? p.a_w_out + (size_t)j * 1024 * 1024 : (type == 1 ? p.b_w_out : p.c_w_out);
                bf16_t* dst = (bf16_t*)(p.ws + OFF_WOUT + (size_t)L * 2 * MBy) + (size_t)nc * 64 * 1024;
                wtile(src, 1024, kt * 64, nc * 64, 64, nullptr, dst, 1024, lds);
            }
        } else {
            const int v = u - N_WT, m = v >> 5, kt = v & 31;
            const float* src = p.a_cmp_w1 + (size_t)m * 2048 * 64;
            bf16_t* dst = (bf16_t*)(p.ws + OFF_W1T) + (size_t)m * 64 * 2048;
            wtile(src, 64, kt * 64, 0, 64, nullptr, dst, 2048, lds);
        }
    }
    for (int item = bid * 4 + wave; item < 256; item += G * 4) {
        const int m = item >> 6, n = item & 63;
        const float* w1 = p.a_cmp_w1 + (size_t)m * 2048 * 64 + n;
        const float* pf = p.a_cmp_pos + (size_t)m * 2048;
        float acc = 0.f;
#pragma unroll 8
        for (int i = 0; i < 32; ++i) { const int k = lane + 64 * i; acc += pf[k] * w1[(size_t)k * 64]; }
#pragma unroll
        for (int o = 32; o >= 1; o >>= 1) acc += __shfl_xor(acc, o);
        if (lane == 0) ((float*)(p.ws + OFF_BIAS1))[m * 64 + n] = acc;
    }
    {
        float* ct = (float*)(p.ws + OFF_COS); float* st = (float*)(p.ws + OFF_SIN);
        for (int i = bid * 256 + tid; i < NT * 32; i += G * 256) {
            const int tok = i >> 5, f = i & 31;
            const float inv_freq = (float)exp2(-(double)f * (13.287712379549449 / 32.0));
            const float ang = (float)p.pos[tok] * inv_freq;
            double rev = (double)ang * 0.15915494309189535; rev -= rint(rev);
            ct[i] = __builtin_amdgcn_cosf((float)rev);
            st[i] = __builtin_amdgcn_sinf((float)rev);
        }
    }
    {
        bf16_t* xb = (bf16_t*)(p.ws + OFF_XB); float* rss = (float*)(p.ws + OFF_RSS);
        for (int row = bid * 4 + wave; row < NT; row += G * 4) {
            const float* xr = p.x + (size_t)row * 1024;
            float ss = 0.f;
#pragma unroll
            for (int i = 0; i < 4; ++i) {
                const f32x4 v = *(const f32x4*)(xr + (lane + 64 * i) * 4);
                ss += v[0] * v[0] + v[1] * v[1] + v[2] * v[2] + v[3] * v[3];
                *(u32x2*)(xb + (size_t)row * 1024 + (lane + 64 * i) * 4) = (u32x2){pk_bf16(v[0], v[1]), pk_bf16(v[2], v[3])};
            }
#pragma unroll
            for (int o = 32; o >= 1; o >>= 1) ss += __shfl_xor(ss, o);
            if (lane < 16) rss[(size_t)row * 16 + lane] = lane == 0 ? ss : 0.f;
        }
    }
}

DEV void g_load(const bf16_t* A, const bf16_t* Bt, int m0, int n0, int k0, int tid, u32x4 (&ra)[4], u32x4 (&rb)[4]) {
#pragma unroll
    for (int i = 0; i < 4; ++i) {
        const int ci = tid + 256 * i, row = ci >> 3, cc = ci & 7;
        ra[i] = *(const u32x4*)(A + (size_t)(m0 + row) * 1024 + k0 + cc * 8);
        rb[i] = *(const u32x4*)(Bt + (size_t)(n0 + row) * 1024 + k0 + cc * 8);
    }
}
DEV void g_write(char* buf, int tid, const u32x4 (&ra)[4], const u32x4 (&rb)[4]) {
#pragma unroll
    for (int i = 0; i < 4; ++i) {
        const int ci = tid + 256 * i, row = ci >> 3, cc = ci & 7;
        *(u32x4*)(buf + swz(row, cc)) = ra[i];
        *(u32x4*)(buf + 16384 + swz(row, cc)) = rb[i];
    }
}
DEV void g_issue(const bf16_t* A, const bf16_t* Bt, int m0, int n0, int k0, char* slot, int wave, int lane) {
#pragma unroll
    for (int i = 0; i < 4; ++i) {
        const int pc = wave + 4 * i, row = 8 * pc + (lane >> 3), cc = (lane & 7) ^ ((row >> 1) & 7);
        __builtin_amdgcn_global_load_lds((const unsigned*)(A + (size_t)(m0 + row) * 1024 + k0 + cc * 8), (unsigned*)(slot + pc * 1024), 16, 0, 0);
        __builtin_amdgcn_global_load_lds((const unsigned*)(Bt + (size_t)(n0 + row) * 1024 + k0 + cc * 8), (unsigned*)(slot + 16384 + pc * 1024), 16, 0, 0);
    }
}
DEV void g_compute(const char* buf, f32x4 (&acc)[4][4], int wr, int wc, int l15, int g) {
#pragma unroll
    for (int ks = 0; ks < 2; ++ks) {
        bf16x8 af[4], bfr[4];
#pragma unroll
        for (int mi = 0; mi < 4; ++mi) af[mi] = *(const bf16x8*)(buf + swz(wr * 64 + 16 * mi + l15, 4 * ks + g));
#pragma unroll
        for (int nj = 0; nj < 4; ++nj) bfr[nj] = *(const bf16x8*)(buf + 16384 + swz(wc * 64 + 16 * nj + l15, 4 * ks + g));
        __builtin_amdgcn_s_setprio(1);
#pragma unroll
        for (int mi = 0; mi < 4; ++mi)
#pragma unroll
            for (int nj = 0; nj < 4; ++nj) acc[mi][nj] = mfma16(bfr[nj], af[mi], acc[mi][nj]);
        __builtin_amdgcn_s_setprio(0);
    }
}
DEV void gemm_tile(const bf16_t* A, const bf16_t* Bt, int m0, int n0, char* lds, f32x4 (&acc)[4][4], int par = 0, bool pre_next = false, int nm0 = 0, int nn0 = 0) {
    const int tid = otid(), lane = tid & 63, wave = tid >> 6, wr = wave >> 1, wc = wave & 1, l15 = lane & 15, g = lane >> 4;
#pragma unroll
    for (int mi = 0; mi < 4; ++mi)
#pragma unroll
        for (int nj = 0; nj < 4; ++nj) acc[mi][nj] = (f32x4){0.f, 0.f, 0.f, 0.f};
    if (!par) {
        __syncthreads();
        g_issue(A, Bt, m0, n0, 0, lds, wave, lane);
    }
    for (int kt = 0; kt < 16; ++kt) {
        dma_barrier();
        if (kt + 1 < 16) g_issue(A, Bt, m0, n0, (kt + 1) * 64, lds + ((kt + 1 + par) & 1) * 32768, wave, lane);
        g_compute(lds + ((kt + par) & 1) * 32768, acc, wr, wc, l15, g);
    }
    __syncthreads();
    if (pre_next) g_issue(A, Bt, nm0, nn0, 0, lds + 32768, wave, lane);
}
DEV bool gemm_next(int r, int ntn, int& mt, int& nt) {
    const int G = gridDim.x, bid = blockIdx.x;
    if ((G & 7) == 0) {
        const int x = bid & 7, lb = bid >> 3, nlb = G >> 3;
        const int qi = lb + nlb * r;
        if (qi >= 32 * ntn) return false;
        const int mi = qi & 3, rest = qi >> 2;
        nt = rest % ntn; mt = x * 32 + (rest / ntn) * 4 + mi;
        return true;
    }
    const int t = bid + G * r;
    if (t >= 256 * ntn) return false;
    mt = t / ntn; nt = t - mt * ntn;
    return true;
}

enum { K_SKIP = 0, K_Q, K_KHEAD, K_VHEAD_T, K_VHEAD_N, K_Z, K_GATE, K_FL };

DEV void inproj_epilogue(const Params& p, int L, f32x4 (&acc)[4][4], int m0, int n0, char* lds) {
    const int tid = otid(), lane = tid & 63, wave = tid >> 6, wr = wave >> 1, wc = wave & 1, l15 = lane & 15, g = lane >> 4;
    const int type = layer_type(L), j = layer_j(L);
    const int nc = (n0 >> 6) + wc;
    char* kv = p.ws + OFF_KV;
    int kind = K_SKIP; bool do_norm = false, do_rope = false; const float* gain = nullptr; bf16_t* outp = nullptr; int hg = 0, G_ = 1; float oscale = 1.f;
    if (type == 0) {
        if (nc < 16) { kind = K_Q; do_norm = true; do_rope = true; gain = p.a_q_gain + j * 64; hg = nc; oscale = QSCALE; }
        else if (nc < 40) {
            const int sub = (nc - 16) >> 2; hg = (nc - 16) & 3; G_ = 4;
            if (sub == 0) { kind = K_KHEAD; do_rope = true; outp = (bf16_t*)(kv + A_KC); }
            else if (sub == 1) { kind = K_VHEAD_N; outp = (bf16_t*)(kv + A_VC); }
            else if (sub == 2) { kind = K_KHEAD; do_norm = true; do_rope = true; gain = p.a_k_gain + (j * 3 + 1) * 64; outp = (bf16_t*)(kv + A_KS); }
            else if (sub == 3) { kind = K_VHEAD_T; outp = (bf16_t*)(kv + A_VST); }
            else if (sub == 4) { kind = K_KHEAD; do_norm = true; do_rope = true; gain = p.a_k_gain + (j * 3 + 2) * 64; outp = (bf16_t*)(kv + A_KW); }
            else { kind = K_VHEAD_T; outp = (bf16_t*)(kv + A_VWT); }
        } else if (nc < 56) { kind = K_Z; hg = nc - 40; }
        else if (nc == 56) kind = K_GATE;
    } else if (type == 1) {
        if (nc < 16) { kind = K_Q; do_norm = true; do_rope = true; gain = p.b_q_gain; hg = nc; oscale = QSCALE; }
        else if (nc < 18) { kind = K_KHEAD; do_norm = true; do_rope = true; gain = p.b_k_gain; hg = nc - 16; G_ = 2; outp = (bf16_t*)(kv + B_K); }
        else if (nc < 20) { kind = K_VHEAD_T; hg = nc - 18; G_ = 2; outp = (bf16_t*)(kv + B_VT); }
        else { kind = K_Z; hg = nc - 20; }
    } else {
        if (nc < 16) { kind = K_Q; do_norm = true; gain = p.c_q_gain; hg = nc; oscale = QSCALE; }
        else if (nc < 32) { kind = K_KHEAD; do_norm = true; gain = p.c_k_gain; hg = nc - 16; G_ = 16; outp = (bf16_t*)(kv + C_K); }
        else if (nc < 48) { kind = K_VHEAD_T; hg = nc - 32; G_ = 16; outp = (bf16_t*)(kv + C_VT); }
        else if (nc < 64) { kind = K_Z; hg = nc - 48; }
        else if (nc == 64) kind = K_FL;
    }
    if (kind == K_SKIP) return;
    const float* rss = (const float*)(p.ws + OFF_RSS);
    const float* ct = (const float*)(p.ws + OFF_COS); const float* st = (const float*)(p.ws + OFF_SIN);
    char* stg = lds + wave * 8192;
    const int tok0 = m0 + wr * 64, b0 = tok0 >> 13, s0 = tok0 & (S - 1);
    f32x4 gn[4];
#pragma unroll
    for (int nj = 0; nj < 4; ++nj) gn[nj] = gain ? *(const f32x4*)(gain + 16 * nj + 4 * g) : (f32x4){1.f, 1.f, 1.f, 1.f};
    f32x4 fb = {0.f, 0.f, 0.f, 0.f};
    if (kind == K_FL) fb = *(const f32x4*)(p.c_fbias + 4 * g);
#pragma unroll
    for (int mi = 0; mi < 4; ++mi) {
        const int row = 16 * mi + l15, tok = tok0 + row;
        const int b = tok >> 13, sq = tok & (S - 1);
        const f32x4 pp = *(const f32x4*)(rss + (size_t)tok * 16 + 4 * g);
        const float rstd = rsqrtf(xsum16_32((pp[0] + pp[1]) + (pp[2] + pp[3])) * (1.f / 1024.f) + EPS);
        f32x4 v[4];
#pragma unroll
        for (int nj = 0; nj < 4; ++nj) v[nj] = acc[mi][nj] * rstd;
        if (do_norm) {
            float q2 = 0.f;
#pragma unroll
            for (int nj = 0; nj < 4; ++nj) q2 += v[nj][0] * v[nj][0] + v[nj][1] * v[nj][1] + v[nj][2] * v[nj][2] + v[nj][3] * v[nj][3];
            q2 = xsum16_32(q2);
            const float r = rsqrtf(q2 * (1.f / 64.f) + EPS) * oscale;
#pragma unroll
            for (int nj = 0; nj < 4; ++nj) v[nj] = v[nj] * r * gn[nj];
        }
        if (do_rope) {
#pragma unroll
            for (int nj = 0; nj < 2; ++nj) {
                const f32x4 c = *(const f32x4*)(ct + (size_t)tok * 32 + 16 * nj + 4 * g);
                const f32x4 sn = *(const f32x4*)(st + (size_t)tok * 32 + 16 * nj + 4 * g);
                const f32x4 x1 = v[nj], x2 = v[nj + 2];
                v[nj] = x1 * c - x2 * sn;
                v[nj + 2] = x2 * c + x1 * sn;
            }
        }
        if (kind == K_Z) {
#pragma unroll
            for (int nj = 0; nj < 4; ++nj)
#pragma unroll
                for (int r = 0; r < 4; ++r) v[nj][r] = v[nj][r] / (1.f + __expf(-v[nj][r]));
        }
        if (kind == K_VHEAD_T) {
#pragma unroll
            for (int nj = 0; nj < 4; ++nj)
#pragma unroll
                for (int r = 0; r < 4; ++r) {
                    const int d = 16 * nj + 4 * g + r;
                    *(bf16_t*)(stg + d * 128 + (((row >> 3) ^ (d & 7)) << 4) + (row & 7) * 2) = (bf16_t)(pk_bf16(v[nj][r], 0.f) & 0xffffu);
                }
        } else if (kind == K_GATE) {
            float* o = (float*)(kv + A_GATE) + (size_t)tok * 48 + 4 * g;
#pragma unroll
            for (int nj = 0; nj < 3; ++nj) {
                f32x4 w;
#pragma unroll
                for (int r = 0; r < 4; ++r) w[r] = 1.f / (1.f + __expf(-v[nj][r]));
                *(f32x4*)(o + 16 * nj) = w;
            }
        } else if (kind == K_FL) {
            float* o = (float*)(kv + C_LF);
#pragma unroll
            for (int r = 0; r < 4; ++r) {
                const float xv = v[0][r] + fb[r];
                const float ls = fminf(xv, 0.f) - log1pf(__expf(-fabsf(xv)));
                o[(size_t)(b * 16 + 4 * g + r) * S + sq] = ls;
            }
        } else {
#pragma unroll
            for (int nj = 0; nj < 4; ++nj) {
                const int u = 4 * nj + g;
                *(u32x2*)(stg + row * 128 + (((u >> 1) ^ (row & 7)) << 4) + (u & 1) * 8) = (u32x2){pk_bf16(v[nj][0], v[nj][1]), pk_bf16(v[nj][2], v[nj][3])};
            }
        }
    }
    if (kind == K_GATE || kind == K_FL) return;
    bf16_t* obase; size_t ostride;
    if (kind == K_Q) { obase = (bf16_t*)(p.ws + OFF_Q) + (size_t)tok0 * 1024 + hg * 64; ostride = 1024; }
    else if (kind == K_Z) { obase = (bf16_t*)(p.ws + OFF_ZS) + (size_t)tok0 * 1024 + hg * 64; ostride = 1024; }
    else if (kind == K_VHEAD_T) { obase = outp + ((size_t)(b0 * G_ + hg) * 64) * S + s0; ostride = S; }
    else { obase = outp + ((size_t)(b0 * G_ + hg) * S + s0) * 64; ostride = 64; }
#pragma unroll
    for (int it = 0; it < 8; ++it) {
        const int row = 8 * it + (lane >> 3), cp = lane & 7;
        const u32x4 dv = *(const u32x4*)(stg + row * 128 + (cp << 4));
        *(u32x4*)(obase + (size_t)row * ostride + ((cp ^ (row & 7)) << 3)) = dv;
    }
}

DEV void phase_inproj(const Params& p, int L, char* lds) {
    const int type = layer_type(L);
    const int ntn = layer_ntn(type);
    const bf16_t* A = (const bf16_t*)(p.ws + OFF_XB);
    const bf16_t* Bt = (const bf16_t*)(p.ws + OFF_WIN + (size_t)L * 9 * MBy);
    int mt, nt, par = 0;
    bool have = gemm_next(0, ntn, mt, nt);
    for (int r = 0; have; ++r) {
        int mt2 = 0, nt2 = 0;
        const bool have2 = gemm_next(r + 1, ntn, mt2, nt2);
        f32x4 acc[4][4];
        gemm_tile(A, Bt, mt * 128, nt * 128, lds, acc, par, have2, mt2 * 128, nt2 * 128);
        par = have2 ? 1 : 0;
        inproj_epilogue(p, L, acc, mt * 128, nt * 128, lds);
        mt = mt2; nt = nt2; have = have2;
    }
}

DEV void phase_outproj(const Params& p, int L, char* lds) {
    const int tid = otid(), lane = tid & 63, wave = tid >> 6, wr = wave >> 1, wc = wave & 1, l15 = lane & 15, g = lane >> 4;
    const bf16_t* A = (const bf16_t*)(p.ws + OFF_Q);
    const bf16_t* Bt = (const bf16_t*)(p.ws + OFF_WOUT + (size_t)L * 2 * MBy);
    const float* xin = L == 0 ? p.x : p.out;
    float* xout = p.out;
    bf16_t* xb = (bf16_t*)(p.ws + OFF_XB);
    float* rssn = (float*)(p.ws + OFF_RSS);
    char* stg = lds + wave * 16384;
    for (int r = 0;; ++r) {
        int mt, nt;
        if (!gemm_next(r, 8, mt, nt)) break;
        const int m0 = mt * 128, n0 = nt * 128;
        f32x4 acc[4][4];
        gemm_tile(A, Bt, m0, n0, lds, acc);
#pragma unroll
        for (int mi = 0; mi < 4; ++mi)
#pragma unroll
            for (int nj = 0; nj < 4; ++nj) {
                const int row = 16 * mi + l15, c = 4 * nj + g;
                *(f32x4*)(stg + row * 256 + ((c ^ (row & 15)) << 4)) = acc[mi][nj];
            }
        const size_t gbase = (size_t)(m0 + wr * 64) * 1024 + n0 + wc * 64;
#pragma unroll
        for (int it = 0; it < 16; ++it) {
            const int row = 4 * it + g, c = l15 ^ (row & 15);
            const f32x4 av = *(const f32x4*)(stg + row * 256 + (l15 << 4));
            const size_t off = gbase + (size_t)row * 1024 + 4 * c;
            const f32x4 xn = *(const f32x4*)(xin + off) + av;
            *(f32x4*)(xout + off) = xn;
            if (L < 3) *(u32x2*)(xb + off) = (u32x2){pk_bf16(xn[0], xn[1]), pk_bf16(xn[2], xn[3])};
            float ss = xn[0] * xn[0] + xn[1] * xn[1] + xn[2] * xn[2] + xn[3] * xn[3];
            ss += __builtin_bit_cast(float, __builtin_amdgcn_update_dpp(0, __builtin_bit_cast(int, ss), 0x128, 0xF, 0xF, false));
            ss += __builtin_bit_cast(float, __builtin_amdgcn_update_dpp(0, __builtin_bit_cast(int, ss), 0x124, 0xF, 0xF, false));
            ss += __builtin_bit_cast(float, __builtin_amdgcn_update_dpp(0, __builtin_bit_cast(int, ss), 0x122, 0xF, 0xF, false));
            ss += __builtin_bit_cast(float, __builtin_amdgcn_update_dpp(0, __builtin_bit_cast(int, ss), 0x121, 0xF, 0xF, false));
            if (l15 == 0 && L < 3) rssn[(size_t)(m0 + wr * 64 + row) * 16 + 2 * nt + wc] = ss;
        }
    }
}

DEV int swzK(int row, int chunk) { return row * 128 + ((chunk ^ (((row >> 1) & 1) | (((row >> 3) & 3) << 1))) << 4); }
DEV int koff(int nf, int g) { return 32 * (nf >> 1) + 8 * g + 4 * (nf & 1); }
template <bool HASV>
DEV void kv_issue(const bf16_t* kp, size_t krow, const bf16_t* vp, size_t vrow, char* kb, char* vb, int wave, int lane) {
#pragma unroll
    for (int i = 0; i < 2; ++i) {
        const int pc = wave + 4 * i, row = 8 * pc + (lane >> 3), cp = lane & 7;
        const int ck = cp ^ (((row >> 1) & 1) | (((row >> 3) & 3) << 1));
        __builtin_amdgcn_global_load_lds((const unsigned*)(kp + (size_t)row * krow + ck * 8), (unsigned*)(kb + pc * 1024), 16, 0, 0);
        if (HASV) {
            const int cv = cp ^ ((row >> 1) & 7);
            __builtin_amdgcn_global_load_lds((const unsigned*)(vp + (size_t)row * vrow + cv * 8), (unsigned*)(vb + pc * 1024), 16, 0, 0);
        }
    }
}
template <bool HASV, bool HASC, bool REV, class F>
DEV void kv_loop(char* lds, const bf16_t* kbase, size_t ktile, size_t krow, const bf16_t* vbase, size_t vtile, size_t vrow, const float* cbase, int kt_lo, int kt_hi, F&& body) {
    const int tid = otid(), wave = tid >> 6, lane = tid & 63;
    const int n = kt_hi - kt_lo + 1;
    f32x4 rc = {0.f, 0.f, 0.f, 0.f};
    char* c0 = lds + 65536 + 512;
#define KTI(i) (REV ? kt_hi - (i) : kt_lo + (i))
    kv_issue<HASV>(kbase + (size_t)KTI(0) * ktile, krow, vbase + (size_t)KTI(0) * vtile, vrow, lds, lds + 8192, wave, lane);
    if (HASC) { if (tid < 16) rc = *(const f32x4*)(cbase + (size_t)KTI(0) * 64 + 4 * tid); }
    for (int i = 0; i < n; ++i) {
        char* cb_ = lds + (i & 1) * 16384; char* nb_ = lds + ((i + 1) & 1) * 16384;
        if (HASC) { if (tid < 16) *(f32x4*)(c0 + (i & 1) * 256 + 16 * tid) = rc; }
        dma_barrier();
        if (i + 1 < n) {
            kv_issue<HASV>(kbase + (size_t)KTI(i + 1) * ktile, krow, vbase + (size_t)KTI(i + 1) * vtile, vrow, nb_, nb_ + 8192, wave, lane);
            if (HASC) { if (tid < 16) rc = *(const f32x4*)(cbase + (size_t)KTI(i + 1) * 64 + 4 * tid); }
        }
        body(KTI(i), (const char*)cb_, (const char*)(cb_ + 8192), (const char*)(c0 + (i & 1) * 256));
    }
    __syncthreads();
#undef KTI
}
template <class F>
DEV void kv_loop_wide(char* lds, const bf16_t* kbase, size_t ktile, size_t krow, const bf16_t* vbase, size_t vtile, size_t vrow, int kt_lo, int kt_hi, F&& body) {
    const int tid = otid(), wave = tid >> 6, lane = tid & 63;
    const int n = kt_hi - kt_lo + 1, steps = (n + 1) >> 1;
#define KVI2(st, B) { kv_issue<true>(kbase + (size_t)(kt_lo + 2 * (st)) * ktile, krow, vbase + (size_t)(kt_lo + 2 * (st)) * vtile, vrow, (B), (B) + 8192, wave, lane); \
                      if (2 * (st) + 1 < n) kv_issue<true>(kbase + (size_t)(kt_lo + 2 * (st) + 1) * ktile, krow, vbase + (size_t)(kt_lo + 2 * (st) + 1) * vtile, vrow, (B) + 16384, (B) + 16384 + 8192, wave, lane); }
    KVI2(0, lds);
    for (int st = 0; st < steps; ++st) {
        char* cbuf = lds + (st & 1) * 32768; char* nbuf = lds + ((st + 1) & 1) * 32768;
        dma_barrier();
        if (st + 1 < steps) KVI2(st + 1, nbuf);
        body(kt_lo + 2 * st, (const char*)cbuf, (const char*)(cbuf + 8192), (const char*)nullptr);
        if (2 * st + 1 < n) body(kt_lo + 2 * st + 1, (const char*)(cbuf + 16384), (const char*)(cbuf + 16384 + 8192), (const char*)nullptr);
    }
    __syncthreads();
#undef KVI2
}
DEV void qk2(const char* kb, const bf16x8 (&q)[2][2], f32x4 (&s)[2][4], bool a0, bool a1, int l15, int g) {
    __builtin_amdgcn_s_setprio(1);
#pragma unroll
    for (int hf = 0; hf < 2; ++hf) {
        bf16x8 kf[2][2];
#pragma unroll
        for (int i = 0; i < 2; ++i)
#pragma unroll
            for (int ks = 0; ks < 2; ++ks) {
                const int nf = 2 * hf + i;
                kf[i][ks] = *(const bf16x8*)(kb + swzK(32 * (nf >> 1) + 8 * (l15 >> 2) + 4 * (nf & 1) + (l15 & 3), 4 * ks + g));
            }
#pragma unroll
        for (int i = 0; i < 2; ++i) { s[0][2 * hf + i] = (f32x4){0.f, 0.f, 0.f, 0.f}; s[1][2 * hf + i] = (f32x4){0.f, 0.f, 0.f, 0.f}; }
        if (a0) {
#pragma unroll
            for (int i = 0; i < 2; ++i)
#pragma unroll
                for (int ks = 0; ks < 2; ++ks) s[0][2 * hf + i] = mfma16(kf[i][ks], q[0][ks], s[0][2 * hf + i]);
        }
        if (a1) {
#pragma unroll
            for (int i = 0; i < 2; ++i)
#pragma unroll
                for (int ks = 0; ks < 2; ++ks) s[1][2 * hf + i] = mfma16(kf[i][ks], q[1][ks], s[1][2 * hf + i]);
        }
    }
    __builtin_amdgcn_s_setprio(0);
}
DEV void pv2(const char* vb, const f32x4 (&s)[2][4], f32x4 (&o)[2][4], bool a0, bool a1, int l15, int g) {
    __builtin_amdgcn_s_setprio(1);
#pragma unroll
    for (int ks = 0; ks < 2; ++ks) {
        bf16x8 vf[4];
#pragma unroll
        for (int df = 0; df < 4; ++df) vf[df] = *(const bf16x8*)(vb + swz(16 * df + l15, 4 * ks + g));
        if (a0) {
            const bf16x8 pb0 = as_bf16x8((u32x4){pk_bf16(s[0][2 * ks][0], s[0][2 * ks][1]), pk_bf16(s[0][2 * ks][2], s[0][2 * ks][3]),
                                                 pk_bf16(s[0][2 * ks + 1][0], s[0][2 * ks + 1][1]), pk_bf16(s[0][2 * ks + 1][2], s[0][2 * ks + 1][3])});
#pragma unroll
            for (int df = 0; df < 4; ++df) o[0][df] = mfma16(vf[df], pb0, o[0][df]);
        }
        if (a1) {
            const bf16x8 pb1 = as_bf16x8((u32x4){pk_bf16(s[1][2 * ks][0], s[1][2 * ks][1]), pk_bf16(s[1][2 * ks][2], s[1][2 * ks][3]),
                                                 pk_bf16(s[1][2 * ks + 1][0], s[1][2 * ks + 1][1]), pk_bf16(s[1][2 * ks + 1][2], s[1][2 * ks + 1][3])});
#pragma unroll
            for (int df = 0; df < 4; ++df) o[1][df] = mfma16(vf[df], pb1, o[1][df]);
        }
    }
    __builtin_amdgcn_s_setprio(0);
}
typedef float f32x2 __attribute__((ext_vector_type(2)));
DEV f32x2 pk_add(f32x2 a, f32x2 b) { return a + b; }
DEV f32x2 pk_sub(f32x2 a, f32x2 b) { return a - b; }
DEV float lmax16(const f32x4 (&s)[4]) {
    float mx = fmaxf(fmaxf(fmaxf(s[0][0], s[0][1]), fmaxf(s[0][2], s[0][3])), fmaxf(fmaxf(s[1][0], s[1][1]), fmaxf(s[1][2], s[1][3])));
    return fmaxf(mx, fmaxf(fmaxf(fmaxf(s[2][0], s[2][1]), fmaxf(s[2][2], s[2][3])), fmaxf(fmaxf(s[3][0], s[3][1]), fmaxf(s[3][2], s[3][3]))));
}
DEV void sm_rescale(float mxl, float& m, float& l, f32x4 (&o)[4]) {
    const float mx = xmax16_32(mxl), mn = fmaxf(m, mx), alpha = ex2(m - mn);
    l *= alpha; m = mn;
#pragma unroll
    for (int df = 0; df < 4; ++df) o[df] = o[df] * alpha;
}
DEV void sm_exp(f32x4 (&s)[4], float ms, float& l) {
    const f32x2 nm2 = {-ms, -ms};
    f32x2 acc2 = {0.f, 0.f};
#pragma unroll
    for (int nf = 0; nf < 4; ++nf) {
        f32x2 d0 = pk_add((f32x2){s[nf][0], s[nf][1]}, nm2), d1 = pk_add((f32x2){s[nf][2], s[nf][3]}, nm2);
        d0[0] = ex2(d0[0]); d0[1] = ex2(d0[1]); d1[0] = ex2(d1[0]); d1[1] = ex2(d1[1]);
        s[nf] = (f32x4){d0[0], d0[1], d1[0], d1[1]};
        acc2 = pk_add(acc2, pk_add(d0, d1));
    }
    l += acc2[0] + acc2[1];
}
template <bool LANEMASK>
DEV void softmax_step_t(f32x4 (&s)[4], float& m, float& l, f32x4 (&o)[4], bool on) {
    float mxl = lmax16(s);
    if (LANEMASK) mxl = on ? mxl : NEGB;
    if (__ballot(mxl > m + 4.f) != 0ull) sm_rescale(mxl, m, l, o);
    sm_exp(s, LANEMASK ? (on ? m : 1e30f) : m, l);
}
DEV void softmax_step(f32x4 (&s)[4], float& m, float& l, f32x4 (&o)[4]) { softmax_step_t<false>(s, m, l, o, true); }
DEV void softmax_step2(f32x4 (&s)[2][4], float (&m)[2], float (&l)[2], f32x4 (&o)[2][4]) {
    const float mx0 = lmax16(s[0]), mx1 = lmax16(s[1]);
    if (__ballot(mx0 > m[0] + 4.f || mx1 > m[1] + 4.f) != 0ull) { sm_rescale(mx0, m[0], l[0], o[0]); sm_rescale(mx1, m[1], l[1], o[1]); }
    sm_exp(s[0], m[0], l[0]);
    sm_exp(s[1], m[1], l[1]);
}
DEV void load_q(const bf16_t* qp, bf16x8 (&q)[2], int g) {
    q[0] = *(const bf16x8*)(qp + 8 * g);
    q[1] = *(const bf16x8*)(qp + 32 + 8 * g);
}
DEV void store_og(bf16_t* og, const bf16_t* zs, size_t off, const f32x4 (&o)[4]) {
#pragma unroll
    for (int df = 0; df < 4; ++df) {
        const u32x2 z = *(const u32x2*)(zs + off + 16 * df);
        *(u32x2*)(og + off + 16 * df) = (u32x2){pk_bf16(o[df][0] * bf_lo(z[0]), o[df][1] * bf_hi(z[0])), pk_bf16(o[df][2] * bf_lo(z[1]), o[df][3] * bf_hi(z[1]))};
    }
}

DEV bf16x8 pack_p(const f32x4& lo, const f32x4& hi) {
    return as_bf16x8((u32x4){pk_bf16(lo[0], lo[1]), pk_bf16(lo[2], lo[3]), pk_bf16(hi[0], hi[1]), pk_bf16(hi[2], hi[3])});
}
DEV void phase_attn_fox(const Params& p, char* lds) {
    const int tid = otid(), lane = tid & 63, wave = tid >> 6, l15 = lane & 15, g = lane >> 4;
    bf16_t* Q = (bf16_t*)(p.ws + OFF_Q); const bf16_t* ZS = (const bf16_t*)(p.ws + OFF_ZS);
    const bf16_t* K = (const bf16_t*)(p.ws + OFF_KV + C_K); const bf16_t* VT = (const bf16_t*)(p.ws + OFF_KV + C_VT);
    const float* CUM = (const float*)(p.ws + OFF_KV + C_CUM);
    const int G = gridDim.x;
    for (int it = 0;; ++it) {
        int qt, bh;
        if (G == 512) {
            if (it >= 4) break;
            const int x = blockIdx.x & 7, lb = blockIdx.x >> 3, lq = lb & 31;
            bh = x + 8 * (2 * it + (lb >> 5)); qt = (it & 1) ? 31 - lq : lq;
        } else {
            const int idx = snake_idx(it, blockIdx.x, G);
            if (it * G >= 2048) break;
            if (idx >= 2048) continue;
            qt = 31 - (idx >> 6); bh = idx & 63;
        }
        const int b = bh >> 4, h = bh & 15, q0 = qt * 256;
        bf16x8 q[4][2]; float m[4], l[4]; f32x4 o[4][4];
        const int tw = q0 + wave * 64;
#pragma unroll
        for (int mf = 0; mf < 4; ++mf) {
            const int t = tw + mf * 16 + l15;
            load_q(Q + ((size_t)(b * S + t)) * 1024 + h * 64, q[mf], g);
            m[mf] = NEGB; l[mf] = 0.f;
#pragma unroll
            for (int df = 0; df < 4; ++df) o[mf][df] = (f32x4){0.f, 0.f, 0.f, 0.f};
        }
        const float* cl = CUM + (size_t)bh * S;
        kv_loop<true, true, true>(lds, K + (size_t)bh * S * 64, 64 * 64, 64, VT + (size_t)bh * 64 * S, 64, S, cl, 0, 4 * qt + 3,
            [&](int kt, const char* kb, const char* vb, const char* cb) {
                const int key0 = kt * 64;
                if (key0 > tw + 63) return;
                f32x4 ck[4];
#pragma unroll
                for (int nf = 0; nf < 4; ++nf) ck[nf] = *(const f32x4*)(cb + 4 * koff(nf, g));
                bf16x8 pb[4][2];
#pragma unroll
                for (int pr = 0; pr < 2; ++pr) {
                    const int f0 = 2 * pr, f1 = 2 * pr + 1;
                    const bool a0 = key0 <= tw + f0 * 16 + 15, a1 = key0 <= tw + f1 * 16 + 15;
                    if (a1) {
                        f32x4 s[2][4];
                        const bf16x8 (&qq)[2][2] = *(const bf16x8 (*)[2][2])&q[f0];
                        qk2(kb, qq, s, a0, a1, l15, g);
#pragma unroll
                        for (int j = 0; j < 2; ++j) {
                            const int mf = f0 + j;
                            if (j == 0 ? a0 : a1) {
                                const int t = tw + mf * 16 + l15;
#pragma unroll
                                for (int nf = 0; nf < 4; ++nf) s[j][nf] = s[j][nf] - ck[nf];
                                if (key0 + 63 > tw + mf * 16) {
#pragma unroll
                                    for (int nf = 0; nf < 4; ++nf)
#pragma unroll
                                        for (int r = 0; r < 4; ++r) if (key0 + koff(nf, g) + r > t) s[j][nf][r] = NEGB;
                                }
                            }
                        }
                        if (a0) {
                            float (&mm)[2] = *(float (*)[2])&m[f0]; float (&ll)[2] = *(float (*)[2])&l[f0];
                            f32x4 (&oo)[2][4] = *(f32x4 (*)[2][4])&o[f0];
                            softmax_step2(s, mm, ll, oo);
                        } else softmax_step(s[1], m[f1], l[f1], o[f1]);
#pragma unroll
                        for (int ks = 0; ks < 2; ++ks) { pb[f0][ks] = pack_p(s[0][2 * ks], s[0][2 * ks + 1]); pb[f1][ks] = pack_p(s[1][2 * ks], s[1][2 * ks + 1]); }
                    }
                }
                const bool act0 = key0 <= tw + 15, act1 = key0 <= tw + 31, act2 = key0 <= tw + 47;
                __builtin_amdgcn_s_setprio(1);
#pragma unroll
                for (int ks = 0; ks < 2; ++ks) {
                    bf16x8 vf[4];
#pragma unroll
                    for (int df = 0; df < 4; ++df) vf[df] = *(const bf16x8*)(vb + swz(16 * df + l15, 4 * ks + g));
#pragma unroll
                    for (int df = 0; df < 4; ++df) {
                        if (act0) o[0][df] = mfma16(vf[df], pb[0][ks], o[0][df]);
                        if (act1) o[1][df] = mfma16(vf[df], pb[1][ks], o[1][df]);
                        if (act2) o[2][df] = mfma16(vf[df], pb[2][ks], o[2][df]);
                        o[3][df] = mfma16(vf[df], pb[3][ks], o[3][df]);
                    }
                }
                __builtin_amdgcn_s_setprio(0);
            });
#pragma unroll
        for (int mf = 0; mf < 4; ++mf) {
            const int t = tw + mf * 16 + l15;
            const float inv = 1.f / xsum16_32(l[mf]);
#pragma unroll
            for (int df = 0; df < 4; ++df) o[mf][df] = o[mf][df] * inv;
            store_og(Q, ZS, (size_t)(b * S + t) * 1024 + h * 64 + 4 * g, o[mf]);
        }
    }
}

DEV void phase_attn_swa(const Params& p, char* lds) {
    const int tid = otid(), lane = tid & 63, wave = tid >> 6, l15 = lane & 15, g = lane >> 4;
    bf16_t* Q = (bf16_t*)(p.ws + OFF_Q); const bf16_t* ZS = (const bf16_t*)(p.ws + OFF_ZS);
    const bf16_t* K = (const bf16_t*)(p.ws + OFF_KV + B_K); const bf16_t* VT = (const bf16_t*)(p.ws + OFF_KV + B_VT);
    for (int it = 0;; ++it) {
        int idx;
        if (gridDim.x == 512) { if (it >= 8) break; idx = ((blockIdx.x & 7) << 9) + (blockIdx.x >> 3) + 64 * it; }
        else { idx = blockIdx.x + it * gridDim.x; if (idx >= 4096) break; }
        const int b = idx >> 10, gk = (idx >> 9) & 1, tt = idx & 511, t0 = tt * 16;
        bf16x8 q[2][2]; float m[2], l[2]; f32x4 o[2][4]; int tq[2], hd[2];
#pragma unroll
        for (int mf = 0; mf < 2; ++mf) {
            const int rowid = wave * 32 + mf * 16 + l15;
            tq[mf] = t0 + (rowid >> 3); hd[mf] = gk * 8 + (rowid & 7);
            load_q(Q + ((size_t)(b * S + tq[mf])) * 1024 + hd[mf] * 64, q[mf], g);
            m[mf] = p.b_sinks[hd[mf]] * LOG2E; l[mf] = g == 0 ? 1.f : 0.f;
#pragma unroll
            for (int df = 0; df < 4; ++df) o[mf][df] = (f32x4){0.f, 0.f, 0.f, 0.f};
        }
        const int lo = t0 - 127 < 0 ? 0 : t0 - 127;
        const size_t kvh = (size_t)(b * 2 + gk);
        kv_loop<true, false, false>(lds, K + kvh * S * 64, 64 * 64, 64, VT + kvh * 64 * S, 64, S, (const float*)nullptr, lo >> 6, (t0 + 15) >> 6,
            [&](int kt, const char* kb, const char* vb, const char* cb) {
                const int key0 = kt * 64;
                const int tA0 = t0 + wave * 4, tA1 = tA0 + 2;
                const bool a0 = key0 <= tA0 + 1 && key0 + 63 >= tA0 - 127, a1 = key0 <= tA1 + 1 && key0 + 63 >= tA1 - 127;
                if (!a0 && !a1) return;
                f32x4 s[2][4];
                qk2(kb, q, s, a0, a1, l15, g);
#pragma unroll
                for (int mf = 0; mf < 2; ++mf) {
                    if (mf == 0 ? a0 : a1) {
                        const int t = tq[mf];
                        const int tA = mf == 0 ? tA0 : tA1;
                        if (key0 + 63 > tA || key0 <= tA + 1 - 128) {
#pragma unroll
                            for (int nf = 0; nf < 4; ++nf)
#pragma unroll
                                for (int r = 0; r < 4; ++r) {
                                    const int key = key0 + koff(nf, g) + r;
                                    if (key > t || key <= t - 128) s[mf][nf][r] = NEGB;
                                }
                        }
                        softmax_step(s[mf], m[mf], l[mf], o[mf]);
                    } else {
#pragma unroll
                        for (int nf = 0; nf < 4; ++nf) s[mf][nf] = (f32x4){0.f, 0.f, 0.f, 0.f};
                    }
                }
                pv2(vb, s, o, a0, a1, l15, g);
            });
#pragma unroll
        for (int mf = 0; mf < 2; ++mf) {
            const float inv = 1.f / xsum16_32(l[mf]);
#pragma unroll
            for (int df = 0; df < 4; ++df) o[mf][df] = o[mf][df] * inv;
            store_og(Q, ZS, (size_t)(b * S + tq[mf]) * 1024 + hd[mf] * 64 + 4 * g, o[mf]);
        }
    }
}

DEV void phase_attn_nsa(const Params& p, char* lds) {
    const int tid = otid(), lane = tid & 63, wave = tid >> 6, l15 = lane & 15, g = lane >> 4;
    bf16_t* Q = (bf16_t*)(p.ws + OFF_Q); const bf16_t* ZS = (const bf16_t*)(p.ws + OFF_ZS);
    char* kv = p.ws + OFF_KV;
    const bf16_t* KS = (const bf16_t*)(kv + A_KS); const bf16_t* VST = (const bf16_t*)(kv + A_VST);
    const bf16_t* KW = (const bf16_t*)(kv + A_KW); const bf16_t* VWT = (const bf16_t*)(kv + A_VWT);
    const bf16_t* KCMP = (const bf16_t*)(kv + A_KCMP); const bf16_t* VCMPT = (const bf16_t*)(kv + A_VCMPT);
    const float* GATE = (const float*)(kv + A_GATE);
    float* impA = (float*)(lds + 32768); float* impB = (float*)(lds + 49152);
    unsigned char* selb_base = (unsigned char*)(lds + 65536);
    const int G = gridDim.x;
    for (int it = 0;; ++it) {
        int tt, bg;
        if (G == 512) {
            if (it >= 4) break;
            const int x = blockIdx.x & 7, lb = blockIdx.x >> 3;
            bg = x + 8 * (it >> 1); tt = (it & 1) ? 127 - lb : lb;
        } else {
            const int idx = snake_idx(it, blockIdx.x, G);
            if (it * G >= 2048) break;
            if (idx >= 2048) continue;
            tt = 127 - (idx >> 4); bg = idx & 15;
        }
        const int b = bg >> 2, gk = bg & 3, t0 = tt * 64, cur = tt;
        const int hdv = gk * 4 + (l15 & 3);
        const bf16_t* kc = KCMP + (size_t)bg * 512 * 64; const bf16_t* vc = VCMPT + (size_t)bg * 64 * 512;
        bf16x8 q4[4][2]; int tq4[4];
#pragma unroll
        for (int h = 0; h < 2; ++h) {
            const int t0h = t0 + 32 * h, tw = t0h + wave * 8;
            bf16x8 (&q)[2][2] = *(bf16x8 (*)[2][2])&q4[2 * h];
            int (&tq)[2] = *(int (*)[2])&tq4[2 * h];
            int hd[2] = {hdv, hdv};
            unsigned char* selb = selb_base + h * 512;
            float m[2], l[2]; f32x4 o[2][4];
#pragma unroll
            for (int mf = 0; mf < 2; ++mf) {
                tq[mf] = tw + mf * 4 + (l15 >> 2);
                load_q(Q + ((size_t)(b * S + tq[mf])) * 1024 + hd[mf] * 64, q[mf], g);
            }
            const int ct_hi = t0h >> 10;
#pragma unroll
            for (int mf = 0; mf < 2; ++mf) { m[mf] = NEGB; l[mf] = 0.f; }
            kv_loop<false, false, false>(lds, kc, 64 * 64, 64, kc, 0, 0, (const float*)nullptr, 0, ct_hi,
                [&](int kt, const char* kb, const char* vb, const char* cb) {
                    const int c0 = kt * 64;
                    const bool a0 = 16 * c0 + 31 <= tw + 3, a1 = 16 * c0 + 31 <= tw + 7;
                    if (!a1) return;
                    f32x4 s[2][4];
                    qk2(kb, q, s, a0, a1, l15, g);
#pragma unroll
                    for (int mf = 0; mf < 2; ++mf) {
                        if (mf == 0 ? a0 : a1) {
                            const int t = tq[mf];
                            if (16 * (c0 + 63) + 31 > tw + mf * 4) {
#pragma unroll
                                for (int nf = 0; nf < 4; ++nf)
#pragma unroll
                                    for (int r = 0; r < 4; ++r) {
                                        const int c = c0 + koff(nf, g) + r;
                                        if (16 * c + 31 > t) s[mf][nf][r] = NEGB;
                                    }
                            }
                            const float mxl = lmax16(s[mf]);
                            if (__ballot(mxl > m[mf] + 4.f) != 0ull) {
                                const float mx = xmax16_32(mxl), mn = fmaxf(m[mf], mx);
                                l[mf] *= ex2(m[mf] - mn); m[mf] = mn;
                            }
                            sm_exp(s[mf], m[mf], l[mf]);
                        }
                    }
                });
            float invl[2];
#pragma unroll
            for (int mf = 0; mf < 2; ++mf) {
                const float lt = xsum16_32(l[mf]);
                invl[mf] = (m[mf] > -1e29f) ? 1.f / lt : 0.f;
#pragma unroll
                for (int df = 0; df < 4; ++df) o[mf][df] = (f32x4){0.f, 0.f, 0.f, 0.f};
            }
            kv_loop<true, false, false>(lds, kc, 64 * 64, 64, vc, 64, 512, (const float*)nullptr, 0, ct_hi,
                [&](int kt, const char* kb, const char* vb, const char* cb) {
                    const int c0 = kt * 64;
                    const bool a0 = 16 * c0 + 31 <= tw + 3, a1 = 16 * c0 + 31 <= tw + 7;
                    if (!a1) return;
                    f32x4 s[2][4];
                    qk2(kb, q, s, a0, a1, l15, g);
#pragma unroll
                    for (int mf = 0; mf < 2; ++mf) {
                        if (mf == 0 ? a0 : a1) {
                            const int t = tq[mf];
#pragma unroll
                            for (int nf = 0; nf < 4; ++nf) {
                                if (16 * (c0 + 63) + 31 > tw + mf * 4) {
#pragma unroll
                                    for (int r = 0; r < 4; ++r) {
                                        const int c = c0 + koff(nf, g) + r;
                                        if (16 * c + 31 > t) s[mf][nf][r] = NEGB;
                                    }
                                }
                                {
                                    f32x4 d4 = s[mf][nf] - m[mf];
                                    d4[0] = ex2(d4[0]); d4[1] = ex2(d4[1]); d4[2] = ex2(d4[2]); d4[3] = ex2(d4[3]);
                                    s[mf][nf] = d4 * invl[mf];
                                }
                                float av = s[mf][nf][0] + s[mf][nf][1] + s[mf][nf][2] + 0.5f * s[mf][nf][3], bv = 0.5f * s[mf][nf][3];
                                av = qsum4(av); bv = qsum4(bv);
                                if ((l15 & 3) == 0) {
                                    const int tl = wave * 8 + mf * 4 + (l15 >> 2), n = 16 * kt + 8 * (nf >> 1) + 2 * g + (nf & 1);
                                    impA[tl * 128 + n] = av; impB[tl * 128 + n] = bv;
                                }
                            }
                        } else {
#pragma unroll
                            for (int nf = 0; nf < 4; ++nf) s[mf][nf] = (f32x4){0.f, 0.f, 0.f, 0.f};
                        }
                    }
                    pv2(vb, s, o, a0, a1, l15, g);
                });
#pragma unroll
            for (int mf = 0; mf < 2; ++mf) {
                const float gcv = GATE[(size_t)(b * S + tq[mf]) * 48 + hd[mf]];
#pragma unroll
                for (int df = 0; df < 4; ++df) o[mf][df] = o[mf][df] * gcv;
            }
            {
                const int nforced = cur >= 2 ? 3 : cur + 1;
                int niter = cur - 2; if (niter > 16 - nforced) niter = 16 - nforced; if (niter < 0) niter = 0;
#pragma unroll
                for (int r2 = 0; r2 < 2; ++r2) {
                    const int tl = wave * 8 + r2 * 4 + g;
                    unsigned key[8];
                    const f32x4 a0v = *(const f32x4*)(impA + tl * 128 + 8 * l15), a1v = *(const f32x4*)(impA + tl * 128 + 8 * l15 + 4);
#pragma unroll
                    for (int jj = 0; jj < 8; ++jj) {
                        const int n = 8 * l15 + jj;
                        const float av = jj < 4 ? a0v[jj & 3] : a1v[jj & 3];
                        const float bv = n > 0 ? impB[tl * 128 + n - 1] : 0.f;
                        const float val = av + bv;
                        const bool cand = n >= 1 && n <= cur - 2;
                        key[jj] = cand ? ((__float_as_uint(val) & 0xFFFFFF80u) | (unsigned)(127 - n)) : 0u;
                    }
                    unsigned selbits = 0;
                    for (int i2 = 0; i2 < niter; ++i2) {
                        unsigned mx = key[0];
#pragma unroll
                        for (int jj = 1; jj < 8; ++jj) mx = mx > key[jj] ? mx : key[jj];
                        unsigned t2;
                        t2 = (unsigned)__builtin_amdgcn_update_dpp(0, (int)mx, 0x128, 0xF, 0xF, false); mx = mx > t2 ? mx : t2;
                        t2 = (unsigned)__builtin_amdgcn_update_dpp(0, (int)mx, 0x124, 0xF, 0xF, false); mx = mx > t2 ? mx : t2;
                        t2 = (unsigned)__builtin_amdgcn_update_dpp(0, (int)mx, 0x122, 0xF, 0xF, false); mx = mx > t2 ? mx : t2;
                        t2 = (unsigned)__builtin_amdgcn_update_dpp(0, (int)mx, 0x121, 0xF, 0xF, false); mx = mx > t2 ? mx : t2;
#pragma unroll
                        for (int jj = 0; jj < 8; ++jj) if (key[jj] == mx) { selbits |= 1u << jj; key[jj] = 0u; }
                    }
#pragma unroll
                    for (int jj = 0; jj < 8; ++jj) { const int n = 8 * l15 + jj; if (n == 0 || n == cur || n == cur - 1) selbits |= 1u << jj; }
                    selb[tl * 16 + l15] = (unsigned char)selbits;
                }
            }
            __syncthreads();
#pragma unroll
            for (int mf = 0; mf < 2; ++mf) {
                bf16_t* op = Q + (size_t)(b * S + tq[mf]) * 1024 + hd[mf] * 64 + 4 * g;
#pragma unroll
                for (int df = 0; df < 4; ++df) *(u32x2*)(op + 16 * df) = (u32x2){pk_bf16(o[mf][df][0], o[mf][df][1]), pk_bf16(o[mf][df][2], o[mf][df][3])};
            }
        }
        float m4[4], l4[4]; f32x4 o4[4][4];
#pragma unroll
        for (int f = 0; f < 4; ++f) {
            m4[f] = NEGB; l4[f] = 0.f;
#pragma unroll
            for (int df = 0; df < 4; ++df) o4[f][df] = (f32x4){0.f, 0.f, 0.f, 0.f};
        }
        const size_t kvh = (size_t)bg;
        kv_loop_wide(lds, KS + kvh * S * 64, 64 * 64, 64, VST + kvh * 64 * S, 64, S, 0, cur,
            [&](int kt, const char* kb, const char* vb, const char* cb) {
                const int key0 = kt * 64;
                bool bit[4], act[4];
#pragma unroll
                for (int f = 0; f < 4; ++f) {
                    bit[f] = (selb_base[(f >> 1) * 512 + (wave * 8 + (f & 1) * 4 + (l15 >> 2)) * 16 + (kt >> 3)] >> (kt & 7)) & 1;
                    act[f] = __ballot(bit[f]) != 0ull;
                }
                if (!(act[0] || act[1] || act[2] || act[3])) return;
#pragma unroll
                for (int pr = 0; pr < 2; ++pr) {
                    const int f0 = 2 * pr, f1 = 2 * pr + 1;
                    if (act[f0] || act[f1]) {
                        f32x4 s[2][4];
                        const bf16x8 (&qq)[2][2] = *(const bf16x8 (*)[2][2])&q4[f0];
                        qk2(kb, qq, s, act[f0], act[f1], l15, g);
#pragma unroll
                        for (int j = 0; j < 2; ++j) {
                            const int f = f0 + j;
                            if (act[f]) {
                                if (kt < cur) {
                                    softmax_step_t<true>(s[j], m4[f], l4[f], o4[f], bit[f]);
                                } else {
                                    const int t = tq4[f];
#pragma unroll
                                    for (int nf = 0; nf < 4; ++nf)
#pragma unroll
                                        for (int r = 0; r < 4; ++r) {
                                            const int key = key0 + koff(nf, g) + r;
                                            if (!bit[f] || key > t) s[j][nf][r] = NEGB;
                                        }
                                    softmax_step(s[j], m4[f], l4[f], o4[f]);
                                }
                            }
                        }
                        { f32x4 (&oo)[2][4] = *(f32x4 (*)[2][4])&o4[f0]; pv2(vb, s, oo, act[f0], act[f1], l15, g); }
                    }
                }
            });
#pragma unroll
        for (int f = 0; f < 4; ++f) {
            int tqf = tq4[f]; asm volatile("" : "+v"(tqf));
            const float sc = GATE[(size_t)(b * S + tqf) * 48 + 16 + hdv] / xsum16_32(l4[f]);
#pragma unroll
            for (int df = 0; df < 4; ++df) {
                bf16_t* op = Q + (size_t)(b * S + tqf) * 1024 + hdv * 64 + 4 * g + 16 * df;
                const u32x2 pv = *(const u32x2*)op;
                const f32x4 w = (f32x4){bf_lo(pv[0]), bf_hi(pv[0]), bf_lo(pv[1]), bf_hi(pv[1])} + o4[f][df] * sc;
                *(u32x2*)op = (u32x2){pk_bf16(w[0], w[1]), pk_bf16(w[2], w[3])};
                o4[f][df] = (f32x4){0.f, 0.f, 0.f, 0.f};
            }
            m4[f] = NEGB; l4[f] = 0.f;
        }
        {
            const int lo = t0 - 511 < 0 ? 0 : t0 - 511;
            kv_loop_wide(lds, KW + kvh * S * 64, 64 * 64, 64, VWT + kvh * 64 * S, 64, S, lo >> 6, cur,
                [&](int kt, const char* kb, const char* vb, const char* cb) {
                    const int key0 = kt * 64;
                    int tA[4]; bool act[4];
#pragma unroll
                    for (int f = 0; f < 4; ++f) {
                        tA[f] = t0 + 32 * (f >> 1) + wave * 8 + 4 * (f & 1);
                        act[f] = key0 <= tA[f] + 3 && key0 + 63 >= tA[f] - 511;
                    }
                    if (!(act[0] || act[1] || act[2] || act[3])) return;
    #pragma unroll
                    for (int pr = 0; pr < 2; ++pr) {
                        const int f0 = 2 * pr, f1 = 2 * pr + 1;
                        if (act[f0] || act[f1]) {
                            f32x4 s[2][4];
                            const bf16x8 (&qq)[2][2] = *(const bf16x8 (*)[2][2])&q4[f0];
                            qk2(kb, qq, s, act[f0], act[f1], l15, g);
#pragma unroll
                            for (int j = 0; j < 2; ++j) {
                                const int f = f0 + j;
                                if (act[f] && (key0 + 63 > tA[f] || key0 <= tA[f] + 3 - 512)) {
                                    const int t = tq4[f];
#pragma unroll
                                    for (int nf = 0; nf < 4; ++nf)
#pragma unroll
                                        for (int r = 0; r < 4; ++r) {
                                            const int key = key0 + koff(nf, g) + r;
                                            if (key > t || key <= t - 512) s[j][nf][r] = NEGB;
                                        }
                                }
                            }
                            if (act[f0] && act[f1]) {
                                float (&mm)[2] = *(float (*)[2])&m4[f0]; float (&ll)[2] = *(float (*)[2])&l4[f0];
                                f32x4 (&oo)[2][4] = *(f32x4 (*)[2][4])&o4[f0];
                                softmax_step2(s, mm, ll, oo);
                            } else if (act[f0]) softmax_step(s[0], m4[f0], l4[f0], o4[f0]);
                            else softmax_step(s[1], m4[f1], l4[f1], o4[f1]);
                            { f32x4 (&oo)[2][4] = *(f32x4 (*)[2][4])&o4[f0]; pv2(vb, s, oo, act[f0], act[f1], l15, g); }
                        }
                    }
                });
        }
#pragma unroll
        for (int f = 0; f < 4; ++f) {
            int tqf = tq4[f]; asm volatile("" : "+v"(tqf));
            const float sc = GATE[(size_t)(b * S + tqf) * 48 + 32 + hdv] / xsum16_32(l4[f]);
#pragma unroll
            for (int df = 0; df < 4; ++df) {
                const u32x2 pv = *(const u32x2*)(Q + (size_t)(b * S + tqf) * 1024 + hdv * 64 + 4 * g + 16 * df);
                o4[f][df] = (f32x4){bf_lo(pv[0]), bf_hi(pv[0]), bf_lo(pv[1]), bf_hi(pv[1])} + o4[f][df] * sc;
            }
            store_og(Q, ZS, (size_t)(b * S + tqf) * 1024 + hdv * 64 + 4 * g, o4[f]);
        }
    }
}

DEV void phase_cmp(const Params& p, int L, char* lds) {
    const int tid = otid(), lane = tid & 63, wave = tid >> 6, l15 = lane & 15, g = lane >> 4;
    const int j = layer_j(L);
    char* kv = p.ws + OFF_KV;
    for (int item = blockIdx.x; item < 256; item += gridDim.x) {
        const int kvsel = item >> 7, bg = (item >> 3) & 15, ctile = item & 7, mi = j * 2 + kvsel;
        const bf16_t* Asrc = (const bf16_t*)(kv + (kvsel ? A_VC : A_KC)) + ((size_t)bg * S + (size_t)ctile * 64 * 16) * 64;
        const bf16_t* W1t = (const bf16_t*)(p.ws + OFF_W1T) + (size_t)mi * 64 * 2048;
        f32x4 acc[4];
#pragma unroll
        for (int nj = 0; nj < 4; ++nj) acc[nj] = (f32x4){0.f, 0.f, 0.f, 0.f};
        {
            u32x4 ra[2], rw[2];
            auto ld = [&](int kt) {
#pragma unroll
                for (int i = 0; i < 2; ++i) {
                    const int ci = tid + 256 * i, row = ci >> 3, cc = ci & 7;
                    ra[i] = *(const u32x4*)(Asrc + (size_t)row * 1024 + kt * 64 + cc * 8);
                    rw[i] = *(const u32x4*)(W1t + (size_t)row * 2048 + kt * 64 + cc * 8);
                }
            };
            auto wr = [&](char* buf) {
#pragma unroll
                for (int i = 0; i < 2; ++i) {
                    const int ci = tid + 256 * i, row = ci >> 3, cc = ci & 7;
                    *(u32x4*)(buf + swz(row, cc)) = ra[i];
                    *(u32x4*)(buf + 8192 + swz(row, cc)) = rw[i];
                }
            };
            ld(0); wr(lds); __syncthreads();
            for (int kt = 0; kt < 32; ++kt) {
                char* cb = lds + (kt & 1) * 16384; char* nb = lds + ((kt + 1) & 1) * 16384;
                if (kt < 31) ld(kt + 1);
#pragma unroll
                for (int ks = 0; ks < 2; ++ks) {
                    const bf16x8 af = *(const bf16x8*)(cb + swz(16 * wave + l15, 4 * ks + g));
#pragma unroll
                    for (int nj = 0; nj < 4; ++nj) {
                        const bf16x8 wf = *(const bf16x8*)(cb + 8192 + swz(16 * nj + l15, 4 * ks + g));
                        acc[nj] = mfma16(wf, af, acc[nj]);
                    }
                }
                if (kt < 31) wr(nb);
                __syncthreads();
            }
        }
        const float* b1 = (const float*)(p.ws + OFF_BIAS1) + mi * 64;
#pragma unroll
        for (int nj = 0; nj < 4; ++nj) {
            const f32x4 bb = *(const f32x4*)(b1 + 16 * nj + 4 * g);
#pragma unroll
            for (int r = 0; r < 4; ++r) {
                const float x = acc[nj][r] + bb[r];
                const float u = 0.7978845608028654f * (x + 0.044715f * x * x * x);
                const float th = 1.f - 2.f / (1.f + __expf(2.f * u));
                acc[nj][r] = 0.5f * x * (1.f + th);
            }
        }
        const float* w2 = p.a_cmp_w2 + (size_t)mi * 64 * 64;
        f32x4 out[4];
        bf16x8 hb[2];
#pragma unroll
        for (int ks = 0; ks < 2; ++ks)
            hb[ks] = as_bf16x8((u32x4){pk_bf16(acc[2 * ks][0], acc[2 * ks][1]), pk_bf16(acc[2 * ks][2], acc[2 * ks][3]),
                                       pk_bf16(acc[2 * ks + 1][0], acc[2 * ks + 1][1]), pk_bf16(acc[2 * ks + 1][2], acc[2 * ks + 1][3])});
#pragma unroll
        for (int nf = 0; nf < 4; ++nf) {
            out[nf] = (f32x4){0.f, 0.f, 0.f, 0.f};
#pragma unroll
            for (int ks = 0; ks < 2; ++ks) {
                float wv[8];
#pragma unroll
                for (int jj = 0; jj < 8; ++jj) wv[jj] = w2[(size_t)(32 * ks + 16 * (jj >> 2) + 4 * g + (jj & 3)) * 64 + 16 * nf + l15];
                const bf16x8 wf = as_bf16x8((u32x4){pk_bf16(wv[0], wv[1]), pk_bf16(wv[2], wv[3]), pk_bf16(wv[4], wv[5]), pk_bf16(wv[6], wv[7])});
                out[nf] = mfma16(wf, hb[ks], out[nf]);
            }
        }
        const int c = ctile * 64 + 16 * wave + l15;
        if (kvsel == 0) {
            float q2 = 0.f;
#pragma unroll
            for (int nf = 0; nf < 4; ++nf) q2 += out[nf][0] * out[nf][0] + out[nf][1] * out[nf][1] + out[nf][2] * out[nf][2] + out[nf][3] * out[nf][3];
            q2 = xsum16_32(q2);
            const float r = c < 511 ? rsqrtf(q2 * (1.f / 64.f) + EPS) : 0.f;
            const float* gk = p.a_k_gain + (size_t)(j * 3) * 64;
            bf16_t* o = (bf16_t*)(kv + A_KCMP) + ((size_t)bg * 512 + c) * 64 + 4 * g;
#pragma unroll
            for (int nf = 0; nf < 4; ++nf) {
                const f32x4 gg = *(const f32x4*)(gk + 16 * nf + 4 * g);
                f32x4 w = out[nf] * r * gg;
                if (c >= 511) w = (f32x4){0.f, 0.f, 0.f, 0.f};
                *(u32x2*)(o + 16 * nf) = (u32x2){pk_bf16(w[0], w[1]), pk_bf16(w[2], w[3])};
            }
        } else {
            bf16_t* o = (bf16_t*)(kv + A_VCMPT) + ((size_t)bg * 64 + 4 * g) * 512 + c;
#pragma unroll
            for (int nf = 0; nf < 4; ++nf)
#pragma unroll
                for (int r = 0; r < 4; ++r) o[(size_t)(16 * nf + r) * 512] = c < 511 ? (bf16_t)(pk_bf16(out[nf][r], 0.f) & 0xffffu) : (bf16_t)0;
        }
    }
}

DEV void phase_cum(const Params& p, char* lds) {
    const int tid = otid(), lane = tid & 63, wave = tid >> 6;
    float* wtot = (float*)lds;
    const float* LF = (const float*)(p.ws + OFF_KV + C_LF); float* CUM = (float*)(p.ws + OFF_KV + C_CUM);
    for (int bh = blockIdx.x; bh < 64; bh += gridDim.x) {
        const float* src = LF + (size_t)bh * S + tid * 32;
        float v[32];
#pragma unroll
        for (int i = 0; i < 8; ++i) { const f32x4 x = *(const f32x4*)(src + 4 * i); v[4 * i] = x[0]; v[4 * i + 1] = x[1]; v[4 * i + 2] = x[2]; v[4 * i + 3] = x[3]; }
#pragma unroll
        for (int i = 1; i < 32; ++i) v[i] += v[i - 1];
        float inc = v[31];
#pragma unroll
        for (int o = 1; o < 64; o <<= 1) { const float u = __shfl_up(inc, o); if (lane >= o) inc += u; }
        if (lane == 63) wtot[wave] = inc;
        __syncthreads();
        float base = inc - v[31];
        for (int w = 0; w < wave; ++w) base += wtot[w];
        float* dst = CUM + (size_t)bh * S + tid * 32;
#pragma unroll
        for (int i = 0; i < 8; ++i) *(f32x4*)(dst + 4 * i) = (f32x4){(v[4 * i] + base) * LOG2E, (v[4 * i + 1] + base) * LOG2E, (v[4 * i + 2] + base) * LOG2E, (v[4 * i + 3] + base) * LOG2E};
        __syncthreads();
    }
}

#define PHASE(i, call) { if (ph_lo <= (i) && (i) < ph_hi) { call; if (coop && (i) + 1 < ph_hi) { if (coop == 2) grid.sync(); else xcd_barrier(xb); } } }
__global__ void __launch_bounds__(256, 2) hybrid_trunk_kernel(Params p, int ph_lo, int ph_hi, int coop) {
    __shared__ __attribute__((aligned(16))) char lds[LDS_BYTES];
    cg::grid_group grid = cg::this_grid();
    unsigned* bar = (unsigned*)(p.ws + OFF_BAR);
    XcdBarrier xb; xb.bar = bar; xb.x = 0; xb.st = (volatile LAS unsigned*)(lds + 65536 + 1024);
    if (coop) {
        if (threadIdx.x < 2) xb.st[threadIdx.x] = 0u;
        __syncthreads();
        xb = xcd_barrier_post(bar, xb.st);
    }
    PHASE(0, phase_prologue(p, lds))
    PHASE(1, phase_inproj(p, 0, lds))
    PHASE(2, phase_cmp(p, 0, lds))
    PHASE(3, phase_attn_nsa(p, lds))
    PHASE(4, phase_outproj(p, 0, lds))
    PHASE(5, phase_inproj(p, 1, lds))
    PHASE(6, phase_attn_swa(p, lds))
    PHASE(7, phase_outproj(p, 1, lds))
    PHASE(8, phase_inproj(p, 2, lds))
    PHASE(9, phase_cum(p, lds))
    PHASE(10, phase_attn_fox(p, lds))
    PHASE(11, phase_outproj(p, 2, lds))
    PHASE(12, phase_inproj(p, 3, lds))
    PHASE(13, phase_cmp(p, 3, lds))
    PHASE(14, phase_attn_nsa(p, lds))
    PHASE(15, phase_outproj(p, 3, lds))
}

extern "C" void kernel_launch(void* const* d_in, const int* in_sizes, int n_in, void* d_out, int out_size, void* d_ws, size_t ws_size, hipStream_t stream) {
    static int grid_blocks = 0;
    if (!grid_blocks) {
        int dev = 0, cus = 0, per_cu = 0;
        hipGetDevice(&dev);
        hipDeviceGetAttribute(&cus, hipDeviceAttributeMultiprocessorCount, dev);
        hipOccupancyMaxActiveBlocksPerMultiprocessor(&per_cu, hybrid_trunk_kernel, 256, 0);
        if (per_cu > 2) per_cu = 2;
        if (per_cu < 1) per_cu = 1;
        grid_blocks = cus * per_cu;
    }
    Params p{};
    p.x = (const float*)d_in[0]; p.pos = (const int*)d_in[1]; p.norm_gains = (const float*)d_in[2];
    p.a_w_in = (const float*)d_in[3]; p.a_q_gain = (const float*)d_in[4]; p.a_k_gain = (const float*)d_in[5]; p.a_cmp_pos = (const float*)d_in[6];
    p.a_cmp_w1 = (const float*)d_in[7]; p.a_cmp_w2 = (const float*)d_in[8]; p.a_w_out = (const float*)d_in[9];
    p.b_w_in = (const float*)d_in[10]; p.b_q_gain = (const float*)d_in[11]; p.b_k_gain = (const float*)d_in[12]; p.b_sinks = (const float*)d_in[13]; p.b_w_out = (const float*)d_in[14];
    p.c_w_in = (const float*)d_in[15]; p.c_fbias = (const float*)d_in[16]; p.c_q_gain = (const float*)d_in[17]; p.c_k_gain = (const float*)d_in[18]; p.c_w_out = (const float*)d_in[19];
    p.out = (float*)d_out; p.ws = (char*)d_ws;
#if ONE_LAUNCH
    hipMemsetAsync((char*)d_ws + OFF_BAR, 0, XCD_BAR_WORDS * 4, stream);
    int lo = 0, hi = NPHASE, coop = 1;
    void* args[] = {&p, &lo, &hi, &coop};
    hipError_t e = hipLaunchCooperativeKernel((void*)hybrid_trunk_kernel, dim3(grid_blocks), dim3(256), args, 0, stream);
    if (e != hipSuccess) fprintf(stderr, "cooperative launch failed: %s (grid %d)\n", hipGetErrorString(e), grid_blocks);
#else
#ifdef PHASE_LIST
    const int plist[] = PHASE_LIST;
    for (int i = 0; i < (int)(sizeof(plist) / sizeof(int)); ++i) hybrid_trunk_kernel<<<dim3(grid_blocks), dim3(256), 0, stream>>>(p, plist[i], plist[i] + 1, 0);
#else
    for (int ph = 0; ph < NPHASE; ++ph) hybrid_trunk_kernel<<<dim3(grid_blocks), dim3(256), 0, stream>>>(p, ph, ph + 1, 0);
#endif
#endif
}
```
